# Optimizing an MI355X kernel written in HIP

```python
import math
import jax, jax.numpy as jnp
from jax import lax
import numpy as np

D_MODEL = 2048
BATCH = 2
SEQ = 4096
DEPTH = 1

N_Q_HEADS = 32
N_KV_HEADS = 4
HEAD_DIM = 64
WINDOW = 128
ROPE_THETA = 500000.0
ROT_DIM = HEAD_DIM // 4
SGU_GROUPS = 8
SGU_CH = 128
CHUNK = 128
N_EXPERTS = 64
N_EXPERT_GROUPS = 8
TOPK_GROUPS = 4
TOP_K = 8
D_EXPERT = 512
D_SHARED = 512
ROUTED_SCALE = 2.5
EXPERT_BLOCK = 128

ATTN_W = N_Q_HEADS * HEAD_DIM
KV_W = N_KV_HEADS * HEAD_DIM
SGU_W = SGU_GROUPS * SGU_CH
IN_W = ATTN_W + 2 * KV_W + 2 * SGU_W + 2 * D_MODEL
ALPHA = (2 * DEPTH) ** 0.25
BETA = (8 * DEPTH) ** -0.25
LN_EPS = 1e-5

kernel_name = "hybrid_swa_sgu_moe_deepnorm"


def layer_norm(x, g, b):
    xf = x.astype(jnp.float32)
    mu = jnp.mean(xf, axis=-1, keepdims=True)
    var = jnp.mean(jnp.square(xf - mu), axis=-1, keepdims=True)
    y = (xf - mu) * lax.rsqrt(var + LN_EPS)
    return (y * g.astype(jnp.float32) + b.astype(jnp.float32)).astype(x.dtype)


def partial_rope(x, pos):
    half = ROT_DIM // 2
    inv_freq = ROPE_THETA ** (-jnp.arange(0, ROT_DIM, 2, dtype=jnp.float32) / ROT_DIM)
    ang = pos[:, None] * inv_freq[None, :]
    cos = jnp.cos(ang)[None, :, None, :]
    sin = jnp.sin(ang)[None, :, None, :]
    xr = x[..., :ROT_DIM].astype(jnp.float32)
    x1, x2 = xr[..., :half], xr[..., half:]
    rot = jnp.concatenate([x1 * cos - x2 * sin, x2 * cos + x1 * sin], axis=-1)
    return jnp.concatenate([rot.astype(x.dtype), x[..., ROT_DIM:]], axis=-1)


def sliding_window_attention(q, k, v, sinks):
    B, S = q.shape[0], q.shape[1]
    nb = S // WINDOW
    G = N_Q_HEADS // N_KV_HEADS
    qb = q.reshape(B, nb, WINDOW, N_KV_HEADS, G, HEAD_DIM)

    def band(t):
        padded = jnp.pad(t, ((0, 0), (WINDOW, 0), (0, 0), (0, 0)))
        prev = padded[:, :S].reshape(B, nb, WINDOW, N_KV_HEADS, HEAD_DIM)
        cur = t.reshape(B, nb, WINDOW, N_KV_HEADS, HEAD_DIM)
        return jnp.concatenate([prev, cur], axis=2)

    kb, vb = band(k), band(v)
    s = jnp.einsum('bnqhgd,bnkhd->bnhgqk', qb, kb).astype(jnp.float32) * (HEAD_DIM ** -0.5)
    qi = jnp.arange(WINDOW)[:, None]
    kj = jnp.arange(2 * WINDOW)[None, :]
    in_band = (kj > qi) & (kj <= qi + WINDOW)
    not_pad = (jnp.arange(nb)[:, None, None] > 0) | (kj[None] >= WINDOW)
    valid = in_band[None] & not_pad
    s = jnp.where(valid[None, :, None, None], s, -jnp.inf)
    sink = sinks.astype(jnp.float32).reshape(N_KV_HEADS, G)[None, None, :, :, None, None]
    m = jnp.maximum(jnp.max(s, axis=-1, keepdims=True), sink)
    p = jnp.exp(s - m)
    denom = jnp.sum(p, axis=-1, keepdims=True) + jnp.exp(sink - m)
    p = (p / denom).astype(v.dtype)
    o = jnp.einsum('bnhgqk,bnkhd->bnqhgd', p, vb)
    return o.reshape(B, S, ATTN_W)


def spatial_gating(u, vg, ln_g, ln_b, w_s, b_s):
    B, S = u.shape[0], u.shape[1]
    nc = S // CHUNK
    vn = layer_norm(vg, ln_g, ln_b)
    vc = vn.reshape(B, nc, CHUNK, SGU_GROUPS, SGU_CH)
    causal = jnp.tril(jnp.ones((CHUNK, CHUNK), dtype=bool))
    ws = jnp.where(causal[None], w_s, jnp.zeros_like(w_s))
    sv = jnp.einsum('gts,bnsgc->bntgc', ws, vc) + jnp.transpose(b_s)[None, None, :, :, None]
    return (u * sv.reshape(B, S, SGU_GROUPS, SGU_CH)).reshape(B, S, SGU_W)


def swiglu(x, w1, w3, w2):
    return (jax.nn.silu(x @ w1) * (x @ w3)) @ w2


def route(xf, w_router, router_bias):
    N = xf.shape[0]
    scores = jax.nn.sigmoid((xf @ w_router).astype(jnp.float32))
    biased = scores + router_bias.astype(jnp.float32)
    per_group = N_EXPERTS // N_EXPERT_GROUPS
    grp = biased.reshape(N, N_EXPERT_GROUPS, per_group)
    grp_score = jnp.sum(lax.top_k(grp, 2)[0], axis=-1)
    _, top_g = lax.top_k(grp_score, TOPK_GROUPS)
    gmask = jnp.sum(jax.nn.one_hot(top_g, N_EXPERT_GROUPS, dtype=jnp.float32), axis=1) > 0
    emask = jnp.repeat(gmask, per_group, axis=1)
    masked = jnp.where(emask, biased, -jnp.inf)
    _, idx = lax.top_k(masked, TOP_K)
    w = jnp.take_along_axis(scores, idx, axis=1)
    w = w / (jnp.sum(w, axis=-1, keepdims=True) + 1e-20) * ROUTED_SCALE
    return idx, w


def routed_experts(xf, idx, wts, w1, w3, w2):
    N, D = xf.shape
    A = N * TOP_K
    n_blocks = -(-(A + N_EXPERTS * (EXPERT_BLOCK - 1)) // EXPERT_BLOCK)
    P = n_blocks * EXPERT_BLOCK
    flat_e = idx.reshape(-1)
    flat_tok = jnp.repeat(jnp.arange(N, dtype=jnp.int32), TOP_K)
    flat_w = wts.reshape(-1)
    order = jnp.argsort(flat_e)
    se = flat_e[order]
    counts = jnp.zeros((N_EXPERTS,), jnp.int32).at[flat_e].add(1)
    start = jnp.cumsum(counts) - counts
    padded = (counts + EXPERT_BLOCK - 1) // EXPERT_BLOCK * EXPERT_BLOCK
    pad_end = jnp.cumsum(padded)
    pad_start = pad_end - padded
    dest = pad_start[se] + (jnp.arange(A, dtype=jnp.int32) - start[se])
    tok_buf = jnp.full((P,), N, jnp.int32).at[dest].set(flat_tok[order])
    w_buf = jnp.zeros((P,), jnp.float32).at[dest].set(flat_w[order])
    block_start = jnp.arange(n_blocks, dtype=jnp.int32) * EXPERT_BLOCK
    block_e = jnp.minimum(jnp.searchsorted(pad_end, block_start, side='right'), N_EXPERTS - 1)
    xpad = jnp.concatenate([xf, jnp.zeros((1, D), xf.dtype)], axis=0)

    def one_block(args):
        e, tok, w = args
        xb = xpad[tok]
        return (swiglu(xb, w1[e], w3[e], w2[e]) * w[:, None]).astype(xf.dtype)

    outs = lax.map(one_block, (block_e, tok_buf.reshape(n_blocks, EXPERT_BLOCK),
                               w_buf.reshape(n_blocks, EXPERT_BLOCK)))
    y = jnp.zeros((N + 1, D), xf.dtype).at[tok_buf].add(outs.reshape(P, D))
    return y[:N]


def setup_inputs(seed: int = 0) -> dict:
    key = jax.random.key(seed)
    ks = jax.random.split(key, 24)
    L, D = DEPTH, D_MODEL
    f = jnp.float32
    nrm = lambda k, shape, scale: jax.random.normal(k, shape, f) * scale
    return {
        "x": jax.random.normal(ks[0], (BATCH, SEQ, D), f),
        "w_in": nrm(ks[1], (L, D, IN_W), D ** -0.5),
        "b_in": nrm(ks[2], (L, IN_W), 0.02),
        "sinks": nrm(ks[3], (L, N_Q_HEADS), 0.5),
        "sgu_ln_g": 1.0 + nrm(ks[4], (L, SGU_GROUPS, SGU_CH), 0.05),
        "sgu_ln_b": nrm(ks[5], (L, SGU_GROUPS, SGU_CH), 0.02),
        "w_spatial": nrm(ks[6], (L, SGU_GROUPS, CHUNK, CHUNK), CHUNK ** -0.5),
        "b_spatial": 1.0 + nrm(ks[7], (L, SGU_GROUPS, CHUNK), 0.1),
        "w_branch_attn": nrm(ks[8], (L, ATTN_W, D), ATTN_W ** -0.5),
        "w_branch_sgu": nrm(ks[9], (L, SGU_W, D), SGU_W ** -0.5),
        "w_out": nrm(ks[10], (L, D, D), BETA * D ** -0.5),
        "ln1_g": 1.0 + nrm(ks[11], (L, D), 0.05),
        "ln1_b": nrm(ks[12], (L, D), 0.02),
        "w_router": nrm(ks[13], (L, D, N_EXPERTS), D ** -0.5),
        "router_bias": nrm(ks[14], (L, N_EXPERTS), 0.01),
        "w1": nrm(ks[15], (L, N_EXPERTS, D, D_EXPERT), D ** -0.5),
        "w3": nrm(ks[16], (L, N_EXPERTS, D, D_EXPERT), D ** -0.5),
        "w2": nrm(ks[17], (L, N_EXPERTS, D_EXPERT, D), BETA * D_EXPERT ** -0.5),
        "ws1": nrm(ks[18], (L, D, D_SHARED), D ** -0.5),
        "ws3": nrm(ks[19], (L, D, D_SHARED), D ** -0.5),
        "ws2": nrm(ks[20], (L, D_SHARED, D), BETA * D_SHARED ** -0.5),
        "ln2_g": 1.0 + nrm(ks[21], (L, D), 0.05),
        "ln2_b": nrm(ks[22], (L, D), 0.02),
    }


def reference(x, w_in, b_in, sinks, sgu_ln_g, sgu_ln_b, w_spatial, b_spatial,
              w_branch_attn, w_branch_sgu, w_out, ln1_g, ln1_b, w_router, router_bias,
              w1, w3, w2, ws1, ws3, ws2, ln2_g, ln2_b):
    B, S, D = x.shape
    pos = jnp.arange(S, dtype=jnp.float32)
    splits = list(np.cumsum([ATTN_W, KV_W, KV_W, SGU_W, SGU_W, D_MODEL]))
    for l in range(DEPTH):
        h = x @ w_in[l] + b_in[l]
        q, k, v, u_pre, vg_pre, gate_a, gate_b = jnp.split(h, splits, axis=-1)
        q = partial_rope(q.reshape(B, S, N_Q_HEADS, HEAD_DIM), pos)
        k = partial_rope(k.reshape(B, S, N_KV_HEADS, HEAD_DIM), pos)
        v = v.reshape(B, S, N_KV_HEADS, HEAD_DIM)
        attn = sliding_window_attention(q, k, v, sinks[l])
        u = jax.nn.gelu(u_pre).reshape(B, S, SGU_GROUPS, SGU_CH)
        vg = jax.nn.gelu(vg_pre).reshape(B, S, SGU_GROUPS, SGU_CH)
        sgu = spatial_gating(u, vg, sgu_ln_g[l], sgu_ln_b[l], w_spatial[l], b_spatial[l])
        merged = (jax.nn.sigmoid(gate_a) * (attn @ w_branch_attn[l])
                  + jax.nn.sigmoid(gate_b) * (sgu @ w_branch_sgu[l]))
        x = layer_norm(ALPHA * x + merged @ w_out[l], ln1_g[l], ln1_b[l])
        xf = x.reshape(B * S, D)
        idx, wts = route(xf, w_router[l], router_bias[l])
        ffn = routed_experts(xf, idx, wts, w1[l], w3[l], w2[l]) + swiglu(xf, ws1[l], ws3[l], ws2[l])
        x = layer_norm(ALPHA * x + ffn.reshape(B, S, D), ln2_g[l], ln2_b[l])
    return x
```

```cpp
#include <hip/hip_runtime.h>
#include <cstdio>
#include <cstdint>
#include <cmath>

typedef unsigned short bf16_t;
typedef float f32x4 __attribute__((ext_vector_type(4)));

constexpr int D_MODEL = 2048, BATCH = 2, SEQ = 4096, NTOK = BATCH * SEQ;
constexpr int NQH = 32, NKVH = 4, HD = 64, WINDOW = 128, ROT = 16;
constexpr int SGU_G = 8, SGU_C = 128, CHUNK = 128;
constexpr int NE = 64, NGRP = 8, TOPKG = 4, TOPK = 8, DE = 512, DS = 512;
constexpr int ATTN_W = 2048, KV_W = 256, SGU_W = 1024, IN_W = 8704;
constexpr float ROUTED_SCALE = 2.5f;
constexpr float LN_EPS = 1e-5f;
constexpr int OFF_Q = 0, OFF_K = 2048, OFF_V = 2304, OFF_U = 2560, OFF_VG = 3584, OFF_GA = 4608, OFF_GB = 6656;

__device__ __forceinline__ float bf2f(bf16_t b) { return __uint_as_float(((unsigned)b) << 16); }
__device__ __forceinline__ bf16_t f2bf(float f) { unsigned u = __float_as_uint(f); return (bf16_t)((u + 0x7fffu + ((u >> 16) & 1u)) >> 16); }
__device__ __forceinline__ float ldf(const float* p) { return *p; }
__device__ __forceinline__ float ldf(const bf16_t* p) { return bf2f(*p); }
__device__ __forceinline__ float gelu_tanh(float x) { const float c = 0.7978845608028654f; float t = tanhf(c * (x + 0.044715f * x * x * x)); return 0.5f * x * (1.f + t); }
__device__ __forceinline__ float sigmoidf_(float x) { return 1.f / (1.f + expf(-x)); }

constexpr size_t MiB = 1u << 20;
constexpr size_t WS_CNT = 0;
constexpr size_t WS_SLOT_E = 1 * MiB, WS_SLOT_P = 1 * MiB + 256 * 1024, WS_SLOT_W = 1 * MiB + 512 * 1024;
constexpr size_t WS_TOKL = 2 * MiB;
constexpr size_t WS_ROPE = 4 * MiB;
constexpr size_t WS_HIN = 8 * MiB;
constexpr size_t WS_Q = 280 * MiB, WS_K = 312 * MiB, WS_V = 316 * MiB, WS_U = 320 * MiB, WS_VGG = 336 * MiB, WS_GA = 352 * MiB, WS_GB = 384 * MiB;
constexpr size_t WS_VN = 416 * MiB;
constexpr size_t WS_ATTN = 448 * MiB, WS_SGU = 480 * MiB;
constexpr size_t WS_TA = 496 * MiB, WS_TB = 560 * MiB, WS_MERGED = 624 * MiB;
constexpr size_t WS_Y1 = 656 * MiB, WS_Y1B = 720 * MiB, WS_LOGIT = 754 * MiB;
constexpr size_t WS_HBUF = 8 * MiB, WS_HS = 88 * MiB, WS_SLOTOUT = 96 * MiB, WS_SHOUT = 416 * MiB;
constexpr size_t WS_END = 756 * MiB;

struct GemmArgs {
    const void* A; int lda;
    const float* B; int ldb;
    const float* B2;
    int M, N, K;
    const int* gather; const int* count; int zero_row;
    const float* bias;
    void* C; int ldc;
};

template <typename TA, int EPI>
__device__ __forceinline__ void gemm_tile(const GemmArgs& g, int tm, int tn, float (*As)[68], float (*Bs)[64], float (*Bs2)[64]) {
    const int tid = threadIdx.x, tx = tid & 15, ty = tid >> 4;
    const TA* A = (const TA*)g.A;
    float acc[4][4], acc2[4][4];
#pragma unroll
    for (int i = 0; i < 4; ++i)
#pragma unroll
        for (int j = 0; j < 4; ++j) { acc[i][j] = 0.f; acc2[i][j] = 0.f; }
    const int ar = tid >> 2, ak = (tid & 3) * 4;
    int arow = tm * 64 + ar;
    if (g.gather) { const int cnt = *g.count; arow = (arow < cnt) ? g.gather[arow] : g.zero_row; }
    const TA* ap = A + (size_t)arow * g.lda + ak;
    const int bk = tid >> 4, bn = (tid & 15) * 4;
    const float* bp = g.B + (size_t)bk * g.ldb + tn * 64 + bn;
    const float* bp2 = g.B2 ? g.B2 + (size_t)bk * g.ldb + tn * 64 + bn : nullptr;
    for (int k0 = 0; k0 < g.K; k0 += 16) {
#pragma unroll
        for (int j = 0; j < 4; ++j) As[ak + j][ar] = ldf(ap + k0 + j);
        *(f32x4*)&Bs[bk][bn] = *(const f32x4*)(bp + (size_t)k0 * g.ldb);
        if (EPI == 1) *(f32x4*)&Bs2[bk][bn] = *(const f32x4*)(bp2 + (size_t)k0 * g.ldb);
        __syncthreads();
#pragma unroll
        for (int k = 0; k < 16; ++k) {
            const f32x4 a = *(const f32x4*)&As[k][ty * 4];
            const f32x4 b = *(const f32x4*)&Bs[k][tx * 4];
#pragma unroll
            for (int i = 0; i < 4; ++i)
#pragma unroll
                for (int j = 0; j < 4; ++j) acc[i][j] += a[i] * b[j];
            if (EPI == 1) {
                const f32x4 b2 = *(const f32x4*)&Bs2[k][tx * 4];
#pragma unroll
                for (int i = 0; i < 4; ++i)
#pragma unroll
                    for (int j = 0; j < 4; ++j) acc2[i][j] += a[i] * b2[j];
            }
        }
        __syncthreads();
    }
#pragma unroll
    for (int i = 0; i < 4; ++i) {
        const int row = tm * 64 + ty * 4 + i;
#pragma unroll
        for (int j = 0; j < 4; ++j) {
            const int col = tn * 64 + tx * 4 + j;
            float v = acc[i][j];
            if (g.bias) v += g.bias[col];
            if (EPI == 0) ((float*)g.C)[(size_t)row * g.ldc + col] = v;
            else if (EPI == 1) { const float a1 = v, a2 = acc2[i][j]; ((bf16_t*)g.C)[(size_t)row * g.ldc + col] = f2bf(a1 * sigmoidf_(a1) * a2); }
            else ((bf16_t*)g.C)[(size_t)row * g.ldc + col] = f2bf(v);
        }
    }
}

template <typename TA, int EPI>
__global__ void __launch_bounds__(256) gemm_kernel(GemmArgs g) {
    __shared__ float As[16][68]; __shared__ float Bs[16][64]; __shared__ float Bs2[16][64];
    const int ntn = g.N / 64, ntm = g.M / 64;
    for (int t = blockIdx.x; t < ntn * ntm; t += gridDim.x) gemm_tile<TA, EPI>(g, t / ntn, t % ntn, As, Bs, Bs2);
}

struct MoeArgs {
    const bf16_t* A; int lda; int K;
    const float* B; const float* B2; size_t estride; int ldb; int N;
    const int* counts; const int* pad_start; const int* tokl;
    bf16_t* C; int ldc;
    int mode;
};
__global__ void __launch_bounds__(256) moe_kernel(MoeArgs m) {
    __shared__ float As[16][68]; __shared__ float Bs[16][64]; __shared__ float Bs2[16][64];
    __shared__ int s_cnt;
    const int ntn = m.N / 64;
    const int per_e = 128 * ntn;
    for (int t = blockIdx.x; t < NE * per_e; t += gridDim.x) {
        const int e = t / per_e, r = t % per_e, tm = r / ntn, tn = r % ntn;
        const int cnt = m.counts[e];
        if (tm * 64 >= cnt) continue;
        const int ps = m.pad_start[e];
        GemmArgs g;
        g.B = m.B + (size_t)e * m.estride; g.B2 = m.B2 ? m.B2 + (size_t)e * m.estride : nullptr; g.ldb = m.ldb;
        g.M = 0; g.N = m.N; g.K = m.K; g.bias = nullptr; g.zero_row = NTOK;
        if (m.mode == 1) {
            if (threadIdx.x == 0) s_cnt = cnt;
            __syncthreads();
            g.A = m.A; g.lda = m.lda; g.gather = m.tokl + (size_t)e * 8192; g.count = &s_cnt;
            g.C = m.C + (size_t)ps * m.ldc; g.ldc = m.ldc;
            gemm_tile<bf16_t, 1>(g, tm, tn, As, Bs, Bs2);
        } else {
            g.A = m.A + (size_t)ps * m.lda; g.lda = m.lda; g.gather = nullptr; g.count = nullptr;
            g.C = m.C + (size_t)ps * m.ldc; g.ldc = m.ldc;
            gemm_tile<bf16_t, 2>(g, tm, tn, As, Bs, Bs2);
        }
        __syncthreads();
    }
}

__global__ void rope_table_kernel(float* tab) {
    const int i = blockIdx.x * blockDim.x + threadIdx.x;
    if (i >= SEQ * 8) return;
    const int pos = i >> 3, f = i & 7;
    const float invf = (float)pow(500000.0, -(double)f / 8.0);
    const float ang = (float)pos * invf;
    tab[2 * i] = (float)cos((double)ang); tab[2 * i + 1] = (float)sin((double)ang);
}

__global__ void post_in_kernel(const float* hin, const float* rope, bf16_t* q, bf16_t* k, bf16_t* v, bf16_t* u, bf16_t* vgg, bf16_t* ga, bf16_t* gb) {
    const size_t i = (size_t)blockIdx.x * blockDim.x + threadIdx.x;
    if (i >= (size_t)NTOK * IN_W) return;
    const int row = (int)(i / IN_W), c = (int)(i % IN_W);
    const float val = hin[i];
    const int pos = row % SEQ;
    if (c < OFF_V) {
        const int d = c & 63;
        float o = val;
        if (d < ROT) {
            const int f = d & 7; const float cs = rope[(pos * 8 + f) * 2], sn = rope[(pos * 8 + f) * 2 + 1];
            if (d < 8) { const float x2 = hin[i + 8]; o = val * cs - x2 * sn; }
            else { const float x1 = hin[i - 8]; o = val * cs + x1 * sn; }
        }
        if (c < OFF_K) q[(size_t)row * ATTN_W + c] = f2bf(o); else k[(size_t)row * KV_W + (c - OFF_K)] = f2bf(o);
    } else if (c < OFF_U) v[(size_t)row * KV_W + (c - OFF_V)] = f2bf(val);
    else if (c < OFF_VG) u[(size_t)row * SGU_W + (c - OFF_U)] = f2bf(gelu_tanh(val));
    else if (c < OFF_GA) vgg[(size_t)row * SGU_W + (c - OFF_VG)] = f2bf(gelu_tanh(val));
    else if (c < OFF_GB) ga[(size_t)row * D_MODEL + (c - OFF_GA)] = f2bf(sigmoidf_(val));
    else gb[(size_t)row * D_MODEL + (c - OFF_GB)] = f2bf(sigmoidf_(val));
}

__global__ void __launch_bounds__(256) attn_kernel(const bf16_t* q, const bf16_t* k, const bf16_t* v, const float* sinks, bf16_t* out) {
    const int i = blockIdx.x * blockDim.x + threadIdx.x;
    if (i >= NTOK * NQH) return;
    const int hq = i % NQH, row = i / NQH, b = row / SEQ, t = row % SEQ, hk = hq / (NQH / NKVH);
    float qr[HD], o[HD];
#pragma unroll
    for (int d = 0; d < HD; ++d) { qr[d] = bf2f(q[(size_t)row * ATTN_W + hq * HD + d]); o[d] = 0.f; }
    float m = sinks[hq], l = 1.f;
    const int s0 = (t - (WINDOW - 1)) > 0 ? (t - (WINDOW - 1)) : 0;
    for (int s = s0; s <= t; ++s) {
        const bf16_t* kr = k + (size_t)(b * SEQ + s) * KV_W + hk * HD;
        const bf16_t* vr = v + (size_t)(b * SEQ + s) * KV_W + hk * HD;
        float sc = 0.f;
#pragma unroll
        for (int d = 0; d < HD; ++d) sc += qr[d] * bf2f(kr[d]);
        sc *= 0.125f;
        const float mn = fmaxf(m, sc), f = expf(m - mn), p = expf(sc - mn);
        l = l * f + p; m = mn;
#pragma unroll
        for (int d = 0; d < HD; ++d) o[d] = o[d] * f + p * bf2f(vr[d]);
    }
    const float inv = 1.f / l;
#pragma unroll
    for (int d = 0; d < HD; ++d) out[(size_t)row * ATTN_W + hq * HD + d] = f2bf(o[d] * inv);
}

__global__ void sgu_ln_kernel(const bf16_t* vgg, const float* g, const float* bta, float* vn) {
    const int i = blockIdx.x * blockDim.x + threadIdx.x;
    if (i >= NTOK * SGU_G) return;
    const int row = i / SGU_G, gi = i % SGU_G;
    const bf16_t* p = vgg + (size_t)row * SGU_W + gi * SGU_C;
    float s = 0.f;
    for (int c = 0; c < SGU_C; ++c) s += bf2f(p[c]);
    const float mu = s / SGU_C; float q = 0.f;
    for (int c = 0; c < SGU_C; ++c) { const float d = bf2f(p[c]) - mu; q += d * d; }
    const float rstd = 1.f / sqrtf(q / SGU_C + LN_EPS);
    for (int c = 0; c < SGU_C; ++c) vn[(size_t)row * SGU_W + gi * SGU_C + c] = (bf2f(p[c]) - mu) * rstd * g[gi * SGU_C + c] + bta[gi * SGU_C + c];
}
__global__ void sgu_mix_kernel(const float* vn, const bf16_t* u, const float* wsp, const float* bsp, bf16_t* out) {
    const size_t i = (size_t)blockIdx.x * blockDim.x + threadIdx.x;
    if (i >= (size_t)NTOK * SGU_W) return;
    const int row = (int)(i / SGU_W), gc = (int)(i % SGU_W), gi = gc / SGU_C;
    const int t = row % CHUNK, base = row - t;
    const float* w = wsp + ((size_t)gi * CHUNK + t) * CHUNK;
    float acc = 0.f;
    for (int s = 0; s <= t; ++s) acc += w[s] * vn[(size_t)(base + s) * SGU_W + gc];
    acc += bsp[gi * CHUNK + t];
    out[i] = f2bf(bf2f(u[i]) * acc);
}
__global__ void merge_kernel(const float* tA, const float* tB, const bf16_t* ga, const bf16_t* gb, bf16_t* merged) {
    const size_t i = (size_t)blockIdx.x * blockDim.x + threadIdx.x;
    if (i >= (size_t)NTOK * D_MODEL) return;
    merged[i] = f2bf(bf2f(ga[i]) * tA[i] + bf2f(gb[i]) * tB[i]);
}
__device__ __forceinline__ float block_sum(float v, float* red) {
#pragma unroll
    for (int o = 32; o > 0; o >>= 1) v += __shfl_xor(v, o);
    __syncthreads();
    if ((threadIdx.x & 63) == 0) red[threadIdx.x >> 6] = v;
    __syncthreads();
    return red[0] + red[1] + red[2] + red[3];
}
__global__ void __launch_bounds__(256) ln1_kernel(const float* x, const float* t, const float* g, const float* bta, float alpha, float* y1, bf16_t* y1b) {
    __shared__ float red[4];
    const int row = blockIdx.x;
    if (row == NTOK) { for (int c = threadIdx.x; c < D_MODEL; c += 256) y1b[(size_t)NTOK * D_MODEL + c] = 0; return; }
    float v[8]; float s = 0.f;
#pragma unroll
    for (int j = 0; j < 8; ++j) { const int c = threadIdx.x + 256 * j; v[j] = alpha * x[(size_t)row * D_MODEL + c] + t[(size_t)row * D_MODEL + c]; s += v[j]; }
    const float mu = block_sum(s, red) / D_MODEL; float qq = 0.f;
#pragma unroll
    for (int j = 0; j < 8; ++j) { const float d = v[j] - mu; qq += d * d; }
    const float rstd = 1.f / sqrtf(block_sum(qq, red) / D_MODEL + LN_EPS);
#pragma unroll
    for (int j = 0; j < 8; ++j) { const int c = threadIdx.x + 256 * j; const float o = (v[j] - mu) * rstd * g[c] + bta[c]; y1[(size_t)row * D_MODEL + c] = o; y1b[(size_t)row * D_MODEL + c] = f2bf(o); }
}

__global__ void __launch_bounds__(256) route_kernel(const float* logits, const float* rbias, int* counts, int* tokl, int* slot_e, int* slot_p, float* slot_w) {
    const int lane = threadIdx.x & 63, t = blockIdx.x * 4 + (threadIdx.x >> 6);
    if (t >= NTOK) return;
    const float score = sigmoidf_(logits[(size_t)t * NE + lane]);
    const float biased = score + rbias[lane];
    const int grp = lane >> 3;
    float m1 = biased;
#pragma unroll
    for (int o = 1; o < 8; o <<= 1) m1 = fmaxf(m1, __shfl_xor(m1, o));
    const unsigned long long eq = __ballot(biased == m1) & (0xFFull << (grp * 8));
    const int first = __ffsll((long long)eq) - 1;
    float m2 = (lane == first) ? -INFINITY : biased;
#pragma unroll
    for (int o = 1; o < 8; o <<= 1) m2 = fmaxf(m2, __shfl_xor(m2, o));
    const float gs = m1 + m2;
    int grank = 0;
#pragma unroll
    for (int g2 = 0; g2 < NGRP; ++g2) { const float o = __shfl(gs, g2 * 8); grank += (o > gs || (o == gs && g2 < grp)) ? 1 : 0; }
    const bool gsel = grank < TOPKG;
    const float masked = gsel ? biased : -INFINITY;
    int rank = 0;
    for (int e2 = 0; e2 < NE; ++e2) { const float o = __shfl(masked, e2); rank += (o > masked || (o == masked && e2 < lane)) ? 1 : 0; }
    const bool sel = gsel && rank < TOPK;
    float wsum = sel ? score : 0.f;
#pragma unroll
    for (int o = 32; o > 0; o >>= 1) wsum += __shfl_xor(wsum, o);
    const unsigned long long sb = __ballot(sel);
    if (sel) {
        const int kidx = __popcll(sb & ((1ull << lane) - 1ull));
        const int pos = atomicAdd(&counts[lane], 1);
        tokl[(size_t)lane * 8192 + pos] = t;
        slot_e[t * TOPK + kidx] = lane; slot_p[t * TOPK + kidx] = pos; slot_w[t * TOPK + kidx] = score / (wsum + 1e-20f) * ROUTED_SCALE;
    }
}
__global__ void pad_start_kernel(const int* counts, int* pad_start) {
    if (threadIdx.x == 0 && blockIdx.x == 0) { int acc = 0; for (int e = 0; e < NE; ++e) { pad_start[e] = acc; acc += (counts[e] + 255) / 256 * 256; } pad_start[NE] = acc; }
}
__global__ void __launch_bounds__(256) final_kernel(const float* y1, const bf16_t* shout, const bf16_t* slotout, const int* slot_e, const int* slot_p, const float* slot_w, const int* pad_start,
                                                    const float* g, const float* bta, float alpha, float* out) {
    __shared__ float red[4];
    const int row = blockIdx.x;
    float v[8];
#pragma unroll
    for (int j = 0; j < 8; ++j) { const int c = threadIdx.x + 256 * j; v[j] = alpha * y1[(size_t)row * D_MODEL + c] + bf2f(shout[(size_t)row * D_MODEL + c]); }
    for (int kk = 0; kk < TOPK; ++kk) {
        const int e = slot_e[row * TOPK + kk], p = slot_p[row * TOPK + kk]; const float w = slot_w[row * TOPK + kk];
        const bf16_t* src = slotout + (size_t)(pad_start[e] + p) * D_MODEL;
#pragma unroll
        for (int j = 0; j < 8; ++j) v[j] += w * bf2f(src[threadIdx.x + 256 * j]);
    }
    float s = 0.f;
#pragma unroll
    for (int j = 0; j < 8; ++j) s += v[j];
    const float mu = block_sum(s, red) / D_MODEL; float qq = 0.f;
#pragma unroll
    for (int j = 0; j < 8; ++j) { const float d = v[j] - mu; qq += d * d; }
    const float rstd = 1.f / sqrtf(block_sum(qq, red) / D_MODEL + LN_EPS);
#pragma unroll
    for (int j = 0; j < 8; ++j) { const int c = threadIdx.x + 256 * j; out[(size_t)row * D_MODEL + c] = (v[j] - mu) * rstd * g[c] + bta[c]; }
}

extern "C" void kernel_launch(void* const* d_in, const int* in_sizes, int n_in, void* d_out, int out_size, void* d_ws, size_t ws_size, hipStream_t stream) {
    if (n_in != 23 || ws_size < WS_END) { fprintf(stderr, "kernel_launch: unexpected n_in %d / ws %zu\n", n_in, ws_size); return; }
    const float* x = (const float*)d_in[0]; const float* w_in = (const float*)d_in[1]; const float* b_in = (const float*)d_in[2]; const float* sinks = (const float*)d_in[3];
    const float* sln_g = (const float*)d_in[4]; const float* sln_b = (const float*)d_in[5]; const float* wsp = (const float*)d_in[6]; const float* bsp = (const float*)d_in[7];
    const float* wA = (const float*)d_in[8]; const float* wB = (const float*)d_in[9]; const float* wo = (const float*)d_in[10]; const float* ln1g = (const float*)d_in[11]; const float* ln1b = (const float*)d_in[12];
    const float* wr = (const float*)d_in[13]; const float* rb = (const float*)d_in[14]; const float* w1 = (const float*)d_in[15]; const float* w3 = (const float*)d_in[16]; const float* w2 = (const float*)d_in[17];
    const float* ws1 = (const float*)d_in[18]; const float* ws3 = (const float*)d_in[19]; const float* ws2 = (const float*)d_in[20]; const float* ln2g = (const float*)d_in[21]; const float* ln2b = (const float*)d_in[22];
    char* ws = (char*)d_ws;
    int* counts = (int*)(ws + WS_CNT); int* pad_start = (int*)(ws + WS_CNT + 1024);
    int* slot_e = (int*)(ws + WS_SLOT_E); int* slot_p = (int*)(ws + WS_SLOT_P); float* slot_w = (float*)(ws + WS_SLOT_W); int* tokl = (int*)(ws + WS_TOKL);
    float* rope = (float*)(ws + WS_ROPE); float* hin = (float*)(ws + WS_HIN);
    bf16_t* q = (bf16_t*)(ws + WS_Q); bf16_t* k = (bf16_t*)(ws + WS_K); bf16_t* v = (bf16_t*)(ws + WS_V); bf16_t* u = (bf16_t*)(ws + WS_U); bf16_t* vgg = (bf16_t*)(ws + WS_VGG);
    bf16_t* ga = (bf16_t*)(ws + WS_GA); bf16_t* gb = (bf16_t*)(ws + WS_GB); float* vn = (float*)(ws + WS_VN);
    bf16_t* attn = (bf16_t*)(ws + WS_ATTN); bf16_t* sgu = (bf16_t*)(ws + WS_SGU); float* tA = (float*)(ws + WS_TA); float* tB = (float*)(ws + WS_TB); bf16_t* merged = (bf16_t*)(ws + WS_MERGED);
    float* y1 = (float*)(ws + WS_Y1); bf16_t* y1b = (bf16_t*)(ws + WS_Y1B); float* logits = (float*)(ws + WS_LOGIT);
    bf16_t* hbuf = (bf16_t*)(ws + WS_HBUF); bf16_t* hs = (bf16_t*)(ws + WS_HS); bf16_t* slotout = (bf16_t*)(ws + WS_SLOTOUT); bf16_t* shout = (bf16_t*)(ws + WS_SHOUT);
    const float alpha = 1.189207115002721f;
    const int G = 2048;

    hipMemsetAsync(ws + WS_CNT, 0, 4096, stream);
    rope_table_kernel<<<(SEQ * 8 + 255) / 256, 256, 0, stream>>>(rope);
    { GemmArgs g{}; g.A = x; g.lda = D_MODEL; g.B = w_in; g.ldb = IN_W; g.B2 = nullptr; g.M = NTOK; g.N = IN_W; g.K = D_MODEL; g.gather = nullptr; g.count = nullptr; g.zero_row = 0; g.bias = b_in; g.C = hin; g.ldc = IN_W;
      gemm_kernel<float, 0><<<G, 256, 0, stream>>>(g); }
    post_in_kernel<<<(unsigned)(((size_t)NTOK * IN_W + 255) / 256), 256, 0, stream>>>(hin, rope, q, k, v, u, vgg, ga, gb);
    attn_kernel<<<(NTOK * NQH + 255) / 256, 256, 0, stream>>>(q, k, v, sinks, attn);
    sgu_ln_kernel<<<(NTOK * SGU_G + 255) / 256, 256, 0, stream>>>(vgg, sln_g, sln_b, vn);
    sgu_mix_kernel<<<(unsigned)(((size_t)NTOK * SGU_W + 255) / 256), 256, 0, stream>>>(vn, u, wsp, bsp, sgu);
    { GemmArgs g{}; g.A = attn; g.lda = ATTN_W; g.B = wA; g.ldb = D_MODEL; g.M = NTOK; g.N = D_MODEL; g.K = ATTN_W; g.C = tA; g.ldc = D_MODEL; gemm_kernel<bf16_t, 0><<<G, 256, 0, stream>>>(g); }
    { GemmArgs g{}; g.A = sgu; g.lda = SGU_W; g.B = wB; g.ldb = D_MODEL; g.M = NTOK; g.N = D_MODEL; g.K = SGU_W; g.C = tB; g.ldc = D_MODEL; gemm_kernel<bf16_t, 0><<<G, 256, 0, stream>>>(g); }
    merge_kernel<<<(unsigned)(((size_t)NTOK * D_MODEL + 255) / 256), 256, 0, stream>>>(tA, tB, ga, gb, merged);
    { GemmArgs g{}; g.A = merged; g.lda = D_MODEL; g.B = wo; g.ldb = D_MODEL; g.M = NTOK; g.N = D_MODEL; g.K = D_MODEL; g.C = tA; g.ldc = D_MODEL; gemm_kernel<bf16_t, 0><<<G, 256, 0, stream>>>(g); }
    ln1_kernel<<<NTOK + 1, 256, 0, stream>>>(x, tA, ln1g, ln1b, alpha, y1, y1b);
    { GemmArgs g{}; g.A = y1; g.lda = D_MODEL; g.B = wr; g.ldb = NE; g.M = NTOK; g.N = NE; g.K = D_MODEL; g.C = logits; g.ldc = NE; gemm_kernel<float, 0><<<128, 256, 0, stream>>>(g); }
    route_kernel<<<NTOK / 4, 256, 0, stream>>>(logits, rb, counts, tokl, slot_e, slot_p, slot_w);
    pad_start_kernel<<<1, 64, 0, stream>>>(counts, pad_start);
    { MoeArgs m{}; m.A = y1b; m.lda = D_MODEL; m.K = D_MODEL; m.B = w1; m.B2 = w3; m.estride = (size_t)D_MODEL * DE; m.ldb = DE; m.N = DE; m.counts = counts; m.pad_start = pad_start; m.tokl = tokl; m.C = hbuf; m.ldc = DE; m.mode = 1;
      moe_kernel<<<4096, 256, 0, stream>>>(m); }
    { GemmArgs g{}; g.A = y1b; g.lda = D_MODEL; g.B = ws1; g.B2 = ws3; g.ldb = DS; g.M = NTOK; g.N = DS; g.K = D_MODEL; g.C = hs; g.ldc = DS; gemm_kernel<bf16_t, 1><<<G, 256, 0, stream>>>(g); }
    { MoeArgs m{}; m.A = hbuf; m.lda = DE; m.K = DE; m.B = w2; m.B2 = nullptr; m.estride = (size_t)DE * D_MODEL; m.ldb = D_MODEL; m.N = D_MODEL; m.counts = counts; m.pad_start = pad_start; m.tokl = tokl; m.C = slotout; m.ldc = D_MODEL; m.mode = 2;
      moe_kernel<<<4096, 256, 0, stream>>>(m); }
    { GemmArgs g{}; g.A = hs; g.lda = DS; g.B = ws2; g.ldb = D_MODEL; g.M = NTOK; g.N = D_MODEL; g.K = DS; g.C = shout; g.ldc = D_MODEL; gemm_kernel<bf16_t, 2><<<G, 256, 0, stream>>>(g); }
    final_kernel<<<NTOK, 256, 0, stream>>>(y1, shout, slotout, slot_e, slot_p, slot_w, pad_start, ln2g, ln2b, alpha, (float*)d_out);
}
```

```cpp
#include <hip/hip_runtime.h>
#include <cstdio>
#include <cstdint>
#include <cmath>

typedef unsigned short bf16_t;
typedef float f32x4 __attribute__((ext_vector_type(4)));
typedef float f32x2 __attribute__((ext_vector_type(2)));
typedef unsigned u32x4 __attribute__((ext_vector_type(4)));
typedef short bf16x8 __attribute__((ext_vector_type(8)));
#define LAS __attribute__((address_space(3)))
#define GAS __attribute__((address_space(1)))

constexpr int D_MODEL = 2048, BATCH = 2, SEQ = 4096, NTOK = BATCH * SEQ;
constexpr int NQH = 32, NKVH = 4, HD = 64, WINDOW = 128, ROT = 16;
constexpr int SGU_G = 8, SGU_C = 128, CHUNK = 128;
constexpr int NE = 64, NGRP = 8, TOPKG = 4, TOPK = 8, DE = 512, DS = 512;
constexpr int ATTN_W = 2048, KV_W = 256, SGU_W = 1024, IN_W = 8704;
constexpr float ROUTED_SCALE = 2.5f;
constexpr float LN_EPS = 1e-5f;
constexpr float ALPHA = 1.189207115002721f;
constexpr int OFF_Q = 0, OFF_K = 2048, OFF_V = 2304, OFF_U = 2560, OFF_VG = 3584, OFF_GA = 4608, OFF_GB = 6656;
constexpr int ZERO_ROW = NTOK;

__device__ __forceinline__ float bf2f(bf16_t b) { return __uint_as_float(((unsigned)b) << 16); }
__device__ __forceinline__ bf16_t f2bf(float f) { unsigned u = __float_as_uint(f); return (bf16_t)((u + 0x7fffu + ((u >> 16) & 1u)) >> 16); }
__device__ __forceinline__ unsigned pk2(float lo, float hi) { return (unsigned)f2bf(lo) | ((unsigned)f2bf(hi) << 16); }
__device__ __forceinline__ float ldf(const float* p) { return *p; }
__device__ __forceinline__ float ldf(const bf16_t* p) { return bf2f(*p); }
__device__ __forceinline__ float gelu_tanh(float x) { const float c = 0.7978845608028654f; float t = tanhf(c * (x + 0.044715f * x * x * x)); return 0.5f * x * (1.f + t); }
__device__ __forceinline__ float sigmoidf_(float x) { return 1.f / (1.f + expf(-x)); }
__device__ __forceinline__ float fsigmoid(float x) { return __builtin_amdgcn_rcpf(1.f + __expf(-x)); }
__device__ __forceinline__ float fgelu(float x) { const float z2 = 1.5957691216057308f * (x + 0.044715f * x * x * x); return x * fsigmoid(z2); }

constexpr size_t MiB = 1u << 20;
constexpr size_t WS_CTL = 0, CTL_ZERO_BYTES = 1 * MiB;
constexpr size_t WS_SLOT_E = 1 * MiB, WS_SLOT_P = 1 * MiB + 256 * 1024, WS_SLOT_W = 1 * MiB + 512 * 1024;
constexpr size_t WS_TOKL = 2 * MiB;
constexpr size_t WS_ROPE = 4 * MiB;
constexpr size_t WS_WT13 = 6 * MiB;
constexpr size_t WS_WT2 = 262 * MiB;
constexpr size_t WS_WTS13 = 390 * MiB;
constexpr size_t WS_WTS2 = 394 * MiB;
constexpr size_t WS_Y1 = 396 * MiB;
constexpr size_t WS_Y1B = 460 * MiB;
constexpr size_t WS_H = 494 * MiB;
constexpr size_t WS_OUT = 582 * MiB;
constexpr size_t WS_WTIN = 582 * MiB;
constexpr size_t WS_XB = 616 * MiB;
constexpr size_t WS_Q = 648 * MiB, WS_K = 680 * MiB, WS_V = 684 * MiB, WS_U = 688 * MiB, WS_VGG = 704 * MiB, WS_GA = 720 * MiB, WS_GB = 752 * MiB;
constexpr size_t WS_ATTN = 784 * MiB, WS_SGU = 816 * MiB, WS_MERGED = 832 * MiB;
constexpr size_t WS_WTA = 864 * MiB, WS_WTB = 872 * MiB, WS_WTO = 876 * MiB;
constexpr size_t WS_Y1PRE = 934 * MiB;
constexpr size_t WS_END = 998 * MiB;
constexpr size_t WS_TA = 494 * MiB, WS_TB = 558 * MiB, WS_VN = 934 * MiB, WS_LOGIT = 966 * MiB;
constexpr int SLOT_ROWS = 81920;

namespace pg8 {
constexpr int BM = 256, BK = 64, HALF = 128, HTB = HALF * BK * 2, STAGE_BYTES = 8 * HTB, NXCD = 8, WGM = 8;
__host__ __device__ __forceinline__ int lds_byte(int r, int c) { const int st = (r >> 4) * 2 + (c >> 5), rr = r & 15, cc = c & 31, ob = rr * 64 + cc * 2; return st * 1024 + (ob ^ (((ob >> 9) & 1) << 5)); }
__host__ __device__ __forceinline__ void stage_rc(int b, int& R, int& C) { const int st = b / 1024, sb = b % 1024, swz = sb ^ (((sb >> 9) & 1) << 5); R = (st >> 1) * 16 + swz / 64; C = (st & 1) * 32 + (swz % 64) / 2; }
__host__ __device__ __forceinline__ int perm32(int rho) { const int n = rho >> 4, i = rho & 15; return 8 * (i >> 2) + 4 * n + (i & 3); }

struct Unit {
    const char* A;
    const char* B;
    const int* gl;
    int gcnt, K;
    int pm, pn, aux;
    int chain;
};

__device__ __forceinline__ unsigned cvt_pk_bf16(float lo, float hi) { unsigned r; asm volatile("v_cvt_pk_bf16_f32 %0, %1, %2" : "=v"(r) : "v"(lo), "v"(hi)); return r; }

__device__ __forceinline__ void unit_offsets(const Unit& u, const int (&R)[2], const int (&C)[2], const int (&Rb)[2], unsigned (&vA)[2][2], unsigned (&vB)[2]) {
#pragma unroll
    for (int i = 0; i < 2; ++i) {
        vB[i] = (unsigned)(Rb[i] * u.K + C[i]) * 2u;
#pragma unroll
        for (int h = 0; h < 2; ++h) {
            int row = R[i] + HALF * h;
            if (u.gl) row = (row < u.gcnt) ? u.gl[row] : ZERO_ROW;
            vA[h][i] = (unsigned)(row * u.K + C[i]) * 2u;
        }
    }
    if (u.gl) asm volatile("" :: "v"(vA[0][0]), "v"(vA[0][1]), "v"(vA[1][0]), "v"(vA[1][1]));
}

template <class Epi, class Sched>
__device__ __forceinline__ void gemm_phase(LAS unsigned char* lds, const Sched& S, const Epi& E) {
    const int tid = threadIdx.x, wid = __builtin_amdgcn_readfirstlane(tid >> 6), lane = tid & 63, wr = wid >> 2, wc = wid & 3, fr = lane & 15, fq = lane >> 4;
    int R[2], C[2], Rb[2];
#pragma unroll
    for (int i = 0; i < 2; ++i) { stage_rc(tid * 16 + i * 8192, R[i], C[i]); Rb[i] = Epi::PERM ? ((R[i] & ~31) + perm32(R[i] & 31)) : R[i]; }
    const size_t kstep = (size_t)(BK * 2);
    const unsigned ldsw = (unsigned)wid * 1024u;
    const int aoff = lds_byte(wr * 64 + fr, fq * 8), boff = lds_byte(wc * 32 + fr, fq * 8);
#define PG8_SA(b, h) (((b) * 2 + (h)) * HTB)
#define PG8_SB(b, h) ((4 + (b) * 2 + (h)) * HTB)
#define PG8_STAGE(bufoff, gbase, voff) do { _Pragma("unroll") for (int _i = 0; _i < 2; ++_i) \
        __builtin_amdgcn_global_load_lds((const unsigned*)((const char*)(gbase) + (voff)[_i]), (LAS unsigned*)(lds + (bufoff) + ldsw + _i * 8192), 16, 0, 0); } while (0)
#define PG8_LDA(dst, b, h) do { _Pragma("unroll") for (int m = 0; m < 4; ++m) _Pragma("unroll") for (int k = 0; k < 2; ++k) dst[m][k] = *(const LAS bf16x8*)(lds + PG8_SA(b, h) + aoff + m * 2048 + k * 1024); } while (0)
#define PG8_LDB(dst, b, h) do { _Pragma("unroll") for (int n = 0; n < 2; ++n) _Pragma("unroll") for (int k = 0; k < 2; ++k) dst[n][k] = *(const LAS bf16x8*)(lds + PG8_SB(b, h) + boff + n * 2048 + k * 1024); } while (0)
#define PG8_MMA(ai, bj, At, Bt) do { __builtin_amdgcn_s_setprio(1); _Pragma("unroll") for (int m = 0; m < 4; ++m) _Pragma("unroll") for (int n = 0; n < 2; ++n) _Pragma("unroll") for (int k = 0; k < 2; ++k) \
        acc[ai][bj][m][n] = __builtin_amdgcn_mfma_f32_16x16x32_bf16(Bt[n][k], At[m][k], acc[ai][bj][m][n], 0, 0, 0); __builtin_amdgcn_s_setprio(0); } while (0)
#define PG8_WAIT_V(n) asm volatile("s_waitcnt vmcnt(" #n ")" ::: "memory")
#define PG8_WAIT_L(n) asm volatile("s_waitcnt lgkmcnt(" #n ")" ::: "memory")
#define PG8_BAR __builtin_amdgcn_s_barrier()
#define PG8_SCHED __builtin_amdgcn_sched_barrier(0)
    Unit cur, nxt; int ui = 0;
    if (!S.next(0, cur)) return;
    f32x4 acc[2][2][4][2];
#pragma unroll
    for (int a = 0; a < 2; ++a)
#pragma unroll
        for (int b = 0; b < 2; ++b)
#pragma unroll
            for (int m = 0; m < 4; ++m)
#pragma unroll
                for (int n = 0; n < 2; ++n) acc[a][b][m][n] = (f32x4){0.f, 0.f, 0.f, 0.f};
    bf16x8 At[4][2], B0[2][2], B1[2][2];
    unsigned cvA[2][2], cvB[2], nvA[2][2], nvB[2];
    unit_offsets(cur, R, C, Rb, cvA, cvB);
    const char* cA = cur.A; const char* cB = cur.B; size_t chs = (size_t)HALF * cur.K * 2;
    PG8_STAGE(PG8_SB(0, 0), cB, cvB); PG8_STAGE(PG8_SB(0, 1), cB + chs, cvB); PG8_STAGE(PG8_SA(0, 0), cA, cvA[0]); PG8_STAGE(PG8_SA(0, 1), cA, cvA[1]);
    if (wr == 1) PG8_BAR;
    PG8_WAIT_V(2); PG8_BAR;
    PG8_STAGE(PG8_SB(1, 0), cB + kstep, cvB); PG8_STAGE(PG8_SA(1, 0), cA + kstep, cvA[0]); PG8_STAGE(PG8_SB(1, 1), cB + chs + kstep, cvB);
    PG8_WAIT_V(6); PG8_BAR;
    for (;;) {
        const bool has_next = S.next(ui + 1, nxt);
        const char* nA = cA; const char* nB = cB; size_t nhs = chs;
        if (has_next) { unit_offsets(nxt, R, C, Rb, nvA, nvB); nA = nxt.A; nB = nxt.B; nhs = (size_t)HALF * nxt.K * 2; }
        else {
#pragma unroll
            for (int i = 0; i < 2; ++i) { nvB[i] = cvB[i]; nvA[0][i] = cvA[0][i]; nvA[1][i] = cvA[1][i]; }
        }
        const int nt = cur.K / BK;
        for (int t = 0; t < nt; t += 2) {
            const bool last = (t == nt - 2);
            const char* a1 = cA + (size_t)(t + 1) * kstep;
            const char* a2 = last ? nA : cA + (size_t)(t + 2) * kstep; const char* b2 = last ? nB : cB + (size_t)(t + 2) * kstep;
            const char* a3 = a2 + kstep; const char* b3 = b2 + kstep;
            const size_t hs2 = last ? nhs : chs;
            unsigned vA2[2][2], vB2[2];
#pragma unroll
            for (int i = 0; i < 2; ++i) { vB2[i] = last ? nvB[i] : cvB[i]; vA2[0][i] = last ? nvA[0][i] : cvA[0][i]; vA2[1][i] = last ? nvA[1][i] : cvA[1][i]; }
            PG8_LDB(B0, 0, 0); PG8_LDB(B1, 0, 1); PG8_SCHED; PG8_LDA(At, 0, 0); PG8_STAGE(PG8_SA(1, 1), a1, cvA[1]);
            PG8_WAIT_V(8); PG8_WAIT_L(0); PG8_BAR; PG8_MMA(0, 0, At, B0); PG8_MMA(0, 1, At, B1); PG8_BAR; PG8_SCHED;
            PG8_LDA(At, 0, 1); PG8_STAGE(PG8_SB(0, 0), b2, vB2); PG8_STAGE(PG8_SB(0, 1), b2 + hs2, vB2); PG8_STAGE(PG8_SA(0, 0), a2, vA2[0]);
            PG8_WAIT_V(8); PG8_WAIT_L(0); PG8_BAR; PG8_MMA(1, 0, At, B0); PG8_MMA(1, 1, At, B1); PG8_BAR; PG8_SCHED;
            PG8_LDB(B0, 1, 0); PG8_LDB(B1, 1, 1); PG8_SCHED; PG8_LDA(At, 1, 0); PG8_STAGE(PG8_SA(0, 1), a2, vA2[1]);
            PG8_WAIT_V(8); PG8_WAIT_L(0); PG8_BAR; PG8_MMA(0, 0, At, B0); PG8_MMA(0, 1, At, B1); PG8_BAR; PG8_SCHED;
            PG8_LDA(At, 1, 1); PG8_STAGE(PG8_SB(1, 0), b3, vB2); PG8_STAGE(PG8_SB(1, 1), b3 + hs2, vB2); PG8_STAGE(PG8_SA(1, 0), a3, vA2[0]);
            PG8_WAIT_V(8); PG8_WAIT_L(0); PG8_BAR; PG8_MMA(1, 0, At, B0); PG8_MMA(1, 1, At, B1); PG8_BAR; PG8_SCHED;
        }
        if (wr == 0) PG8_BAR;
        E(acc, cur, wr, wc, fr, fq);
        if (!has_next) break;
        if (cur.chain != 1) {
#pragma unroll
            for (int a = 0; a < 2; ++a)
#pragma unroll
                for (int b = 0; b < 2; ++b)
#pragma unroll
                    for (int m = 0; m < 4; ++m)
#pragma unroll
                        for (int n = 0; n < 2; ++n) acc[a][b][m][n] = (f32x4){0.f, 0.f, 0.f, 0.f};
        }
        cur = nxt; cA = nA; cB = nB; chs = nhs; ++ui;
#pragma unroll
        for (int i = 0; i < 2; ++i) { cvB[i] = nvB[i]; cvA[0][i] = nvA[0][i]; cvA[1][i] = nvA[1][i]; }
        if (wr == 1) PG8_BAR;
    }
    PG8_WAIT_V(0);
    PG8_BAR;
#undef PG8_SA
#undef PG8_SB
#undef PG8_STAGE
#undef PG8_LDA
#undef PG8_LDB
#undef PG8_MMA
#undef PG8_WAIT_V
#undef PG8_WAIT_L
#undef PG8_BAR
#undef PG8_SCHED
}

struct TileOrder {
    int nM, nN, nwg, G, c;
    __device__ void init(int nM_, int nN_, int G_, int c_) { nM = nM_; nN = nN_; nwg = nM * nN; G = G_; c = c_; }
    __device__ __forceinline__ bool tile(int i, int& pm, int& pn) const {
        const long L = (long)i * G + c; if (L >= nwg) return false;
        int wgid = (int)L; { const int q = nwg / NXCD, r = nwg % NXCD, xcd = wgid % NXCD, off = wgid / NXCD; wgid = (xcd < r ? xcd * (q + 1) : r * (q + 1) + (xcd - r) * q) + off; }
        const int nig = WGM * nN, gid = wgid / nig, fm = gid * WGM, gsz = (nM - fm) < WGM ? (nM - fm) : WGM;
        pm = fm + ((wgid % nig) % gsz); pn = (wgid % nig) / gsz; return true;
    }
};
struct DenseSched {
    TileOrder o; const char* A; const char* Bt; int K;
    __device__ __forceinline__ bool next(int i, Unit& u) const {
        int pm, pn; if (!o.tile(i, pm, pn)) return false;
        u.A = A + (size_t)pm * BM * K * 2; u.B = Bt + (size_t)pn * BM * K * 2; u.gl = nullptr; u.gcnt = 0; u.K = K; u.pm = pm; u.pn = pn; u.aux = 0; u.chain = 0; return true;
    }
};

struct EpiIn {
    static constexpr bool PERM = true;
    const float* bias; const float* rope; bf16_t *q, *k, *v, *u, *vgg, *ga, *gb;
    __device__ __forceinline__ void operator()(f32x4 (&acc)[2][2][4][2], const Unit& un, int wr, int wc, int fr, int fq) const {
        const int colt = un.pn * BM;
        int kind, ldc, cb; bf16_t* base;
        if (colt < OFF_K) { kind = 0; base = q; ldc = ATTN_W; cb = colt; }
        else if (colt < OFF_V) { kind = 0; base = k; ldc = KV_W; cb = colt - OFF_K; }
        else if (colt < OFF_U) { kind = 1; base = v; ldc = KV_W; cb = colt - OFF_V; }
        else if (colt < OFF_VG) { kind = 2; base = u; ldc = SGU_W; cb = colt - OFF_U; }
        else if (colt < OFF_GA) { kind = 2; base = vgg; ldc = SGU_W; cb = colt - OFF_VG; }
        else if (colt < OFF_GB) { kind = 3; base = ga; ldc = D_MODEL; cb = colt - OFF_GA; }
        else { kind = 3; base = gb; ldc = D_MODEL; cb = colt - OFF_GB; }
        const int row0 = un.pm * BM + wr * 64 + fr, col0 = wc * 32 + 8 * fq;
        f32x4 bv[2][2];
#pragma unroll
        for (int bj = 0; bj < 2; ++bj)
#pragma unroll
            for (int n = 0; n < 2; ++n) bv[bj][n] = *(const f32x4*)(bias + colt + col0 + bj * HALF + 4 * n);
        const bool do_rope = (kind == 0) && ((wc & 1) == 0);
#pragma unroll
        for (int ai = 0; ai < 2; ++ai)
#pragma unroll
            for (int m = 0; m < 4; ++m) {
                const int row = row0 + ai * HALF + m * 16;
                f32x4 cs0 = {1.f, 1.f, 1.f, 1.f}, cs1 = cs0, sn0 = {0.f, 0.f, 0.f, 0.f}, sn1 = sn0;
                if (do_rope && fq < 2) {
                    const f32x4* tp = (const f32x4*)(rope + (size_t)(row % SEQ) * 16);
                    const f32x4 t0 = tp[0], t1 = tp[1], t2 = tp[2], t3 = tp[3];
                    cs0 = (f32x4){t0[0], t0[2], t1[0], t1[2]}; sn0 = (f32x4){t0[1], t0[3], t1[1], t1[3]};
                    cs1 = (f32x4){t2[0], t2[2], t3[0], t3[2]}; sn1 = (f32x4){t2[1], t2[3], t3[1], t3[3]};
                    if (fq == 0) { sn0 = -sn0; sn1 = -sn1; }
                }
#pragma unroll
                for (int bj = 0; bj < 2; ++bj) {
                    f32x4 v0 = acc[ai][bj][m][0] + bv[bj][0], v1 = acc[ai][bj][m][1] + bv[bj][1];
                    if (do_rope) {
                        f32x4 p0, p1;
#pragma unroll
                        for (int j = 0; j < 4; ++j) { p0[j] = __shfl_xor(v0[j], 16); p1[j] = __shfl_xor(v1[j], 16); }
                        v0 = v0 * cs0 + p0 * sn0; v1 = v1 * cs1 + p1 * sn1;
                    } else if (kind == 2) {
#pragma unroll
                        for (int j = 0; j < 4; ++j) { v0[j] = fgelu(v0[j]); v1[j] = fgelu(v1[j]); }
                    } else if (kind == 3) {
#pragma unroll
                        for (int j = 0; j < 4; ++j) { v0[j] = fsigmoid(v0[j]); v1[j] = fsigmoid(v1[j]); }
                    }
                    u32x4 w; w.x = cvt_pk_bf16(v0[0], v0[1]); w.y = cvt_pk_bf16(v0[2], v0[3]); w.z = cvt_pk_bf16(v1[0], v1[1]); w.w = cvt_pk_bf16(v1[2], v1[3]);
                    *(u32x4*)(base + (size_t)row * ldc + cb + col0 + bj * HALF) = w;
                }
            }
    }
};

__device__ __forceinline__ void unpack8(const u32x4 w, float (&f)[8]) {
#pragma unroll
    for (int j = 0; j < 4; ++j) { f[2 * j] = __uint_as_float(w[j] << 16); f[2 * j + 1] = __uint_as_float(w[j] & 0xffff0000u); }
}
struct EpiMerge {
    static constexpr bool PERM = true;
    const bf16_t* ga; const bf16_t* gb; bf16_t* merged;
    __device__ __forceinline__ void operator()(f32x4 (&acc)[2][2][4][2], const Unit& un, int wr, int wc, int fr, int fq) const {
        const int row0 = un.pm * BM + wr * 64 + fr, col0 = un.pn * BM + wc * 32 + 8 * fq;
#pragma unroll
        for (int ai = 0; ai < 2; ++ai)
#pragma unroll
            for (int m = 0; m < 4; ++m) {
                const size_t rowoff = (size_t)(row0 + ai * HALF + m * 16) * D_MODEL + col0;
#pragma unroll
                for (int bj = 0; bj < 2; ++bj) {
                    const size_t off = rowoff + bj * HALF;
                    float fb[8]; unpack8(*(const u32x4*)(gb + off), fb);
                    if (un.chain == 1) {
                        float fa[8]; unpack8(*(const u32x4*)(ga + off), fa);
#pragma unroll
                        for (int j = 0; j < 4; ++j) { acc[ai][bj][m][0][j] *= fa[j] * __builtin_amdgcn_rcpf(fb[j]); acc[ai][bj][m][1][j] *= fa[4 + j] * __builtin_amdgcn_rcpf(fb[4 + j]); }
                    } else {
                        f32x4 v0 = acc[ai][bj][m][0], v1 = acc[ai][bj][m][1];
#pragma unroll
                        for (int j = 0; j < 4; ++j) { v0[j] *= fb[j]; v1[j] *= fb[4 + j]; }
                        u32x4 w; w.x = cvt_pk_bf16(v0[0], v0[1]); w.y = cvt_pk_bf16(v0[2], v0[3]); w.z = cvt_pk_bf16(v1[0], v1[1]); w.w = cvt_pk_bf16(v1[2], v1[3]);
                        *(u32x4*)(merged + off) = w;
                    }
                }
            }
    }
};
struct EpiWo {
    static constexpr bool PERM = false;
    const float* x; float* out;
    __device__ __forceinline__ void operator()(f32x4 (&acc)[2][2][4][2], const Unit& un, int wr, int wc, int fr, int fq) const {
        const int row0 = un.pm * BM + wr * 64 + fr, col0 = un.pn * BM + wc * 32 + 4 * fq;
#pragma unroll
        for (int ai = 0; ai < 2; ++ai)
#pragma unroll
            for (int m = 0; m < 4; ++m) {
                const size_t rowoff = (size_t)(row0 + ai * HALF + m * 16) * D_MODEL + col0;
#pragma unroll
                for (int bj = 0; bj < 2; ++bj)
#pragma unroll
                    for (int n = 0; n < 2; ++n) { const size_t off = rowoff + bj * HALF + n * 16; const f32x4 xv = *(const f32x4*)(x + off); *(f32x4*)(out + off) = xv * ALPHA + acc[ai][bj][m][n]; }
            }
    }
};
struct EpiSwiglu {
    static constexpr bool PERM = true;
    bf16_t* H;
    __device__ __forceinline__ void operator()(f32x4 (&acc)[2][2][4][2], const Unit& un, int wr, int wc, int fr, int fq) const {
        const int row0 = un.aux + wr * 64 + fr, col0 = un.pn * HALF + wc * 32 + 8 * fq;
#pragma unroll
        for (int ai = 0; ai < 2; ++ai)
#pragma unroll
            for (int m = 0; m < 4; ++m) {
                f32x4 g0 = acc[ai][0][m][0], g1 = acc[ai][0][m][1]; const f32x4 u0 = acc[ai][1][m][0], u1 = acc[ai][1][m][1];
#pragma unroll
                for (int j = 0; j < 4; ++j) { g0[j] = g0[j] * fsigmoid(g0[j]) * u0[j]; g1[j] = g1[j] * fsigmoid(g1[j]) * u1[j]; }
                u32x4 w; w.x = cvt_pk_bf16(g0[0], g0[1]); w.y = cvt_pk_bf16(g0[2], g0[3]); w.z = cvt_pk_bf16(g1[0], g1[1]); w.w = cvt_pk_bf16(g1[2], g1[3]);
                *(u32x4*)(H + (size_t)(row0 + ai * HALF + m * 16) * DE + col0) = w;
            }
    }
};
struct EpiOut {
    static constexpr bool PERM = true;
    bf16_t* O;
    __device__ __forceinline__ void operator()(f32x4 (&acc)[2][2][4][2], const Unit& un, int wr, int wc, int fr, int fq) const {
        const int row0 = un.aux + wr * 64 + fr, col0 = un.pn * BM + wc * 32 + 8 * fq;
#pragma unroll
        for (int ai = 0; ai < 2; ++ai)
#pragma unroll
            for (int m = 0; m < 4; ++m)
#pragma unroll
                for (int bj = 0; bj < 2; ++bj) { const f32x4 v0 = acc[ai][bj][m][0], v1 = acc[ai][bj][m][1];
                    u32x4 w; w.x = cvt_pk_bf16(v0[0], v0[1]); w.y = cvt_pk_bf16(v0[2], v0[3]); w.z = cvt_pk_bf16(v1[0], v1[1]); w.w = cvt_pk_bf16(v1[2], v1[3]);
                    *(u32x4*)(O + (size_t)(row0 + ai * HALF + m * 16) * D_MODEL + col0 + bj * HALF) = w; }
    }
};
struct MergeSched {
    TileOrder o; const char* attn; const char* sgu; const char* WtA; const char* WtB;
    __device__ __forceinline__ bool next(int i, Unit& u) const {
        int pm, pn; if (!o.tile(i >> 1, pm, pn)) return false;
        u.gl = nullptr; u.gcnt = 0; u.pm = pm; u.pn = pn; u.aux = 0;
        if ((i & 1) == 0) { u.A = attn + (size_t)pm * BM * ATTN_W * 2; u.B = WtA + (size_t)pn * BM * ATTN_W * 2; u.K = ATTN_W; u.chain = 1; }
        else { u.A = sgu + (size_t)pm * BM * SGU_W * 2; u.B = WtB + (size_t)pn * BM * SGU_W * 2; u.K = SGU_W; u.chain = 2; }
        return true;
    }
};
struct MoeSched {
    TileOrder o; const LAS int* tab; const LAS int* pstart; const LAS int* cnt;
    int mode;
    const char* y1b; const int* tokl; const char* Wt13; const char* WtS13; const char* H; const char* Wt2; const char* WtS2;
    __device__ __forceinline__ bool next(int i, Unit& u) const {
        int pm, pn; if (!o.tile(i, pm, pn)) return false;
        const int ent = __builtin_amdgcn_readfirstlane(tab[pm]); const int e = ent & 255, j = ent >> 8;
        u.pm = pm; u.pn = pn; u.chain = 0; u.gl = nullptr; u.gcnt = 0;
        if (mode == 1) {
            u.K = D_MODEL;
            if (e < NE) { const int ps = __builtin_amdgcn_readfirstlane(pstart[e]), c = __builtin_amdgcn_readfirstlane(cnt[e]);
                u.A = y1b; u.gl = tokl + (size_t)e * 8192 + j * BM; u.gcnt = c - j * BM; u.B = Wt13 + ((size_t)e * 1024 + (size_t)pn * BM) * D_MODEL * 2; u.aux = ps + j * BM; }
            else { u.A = y1b + (size_t)j * BM * D_MODEL * 2; u.B = WtS13 + (size_t)pn * BM * D_MODEL * 2; u.aux = SLOT_ROWS + j * BM; }
        } else {
            u.K = DE;
            if (e < NE) { const int ps = __builtin_amdgcn_readfirstlane(pstart[e]);
                u.A = H + (size_t)(ps + j * BM) * DE * 2; u.B = Wt2 + ((size_t)e * D_MODEL + (size_t)pn * BM) * DE * 2; u.aux = ps + j * BM; }
            else { u.A = H + (size_t)(SLOT_ROWS + j * BM) * DE * 2; u.B = WtS2 + (size_t)pn * BM * DE * 2; u.aux = SLOT_ROWS + j * BM; }
        }
        return true;
    }
};
}

constexpr int NWAVES = 8;
constexpr int RING_OFF = 0, RING_BYTES = 131072;
constexpr int LDSCTL_OFF = RING_BYTES, MISC_OFF = LDSCTL_OFF + 320;
constexpr int LDS_BYTES = 147456;
constexpr int TAB_OFF = LDSCTL_OFF + 1024;
constexpr int CW_BAR = 4096;

#define XB_TMO      128
#define XB_XCNT(j)  (256  + 64 * (j))
#define XB_XSUB(j)  (1280 + 64 * (j))
#define XB_XGEN(j)  (2304 + 64 * (j))
#define XB_TOP      3328
#define XB_TOPGEN   3392
#define XCD_BAR_WORDS 3456
#define XB_SPIN_CAP (1u << 18)
__device__ __forceinline__ unsigned xb_ld(unsigned* p)              { return __hip_atomic_load(p, __ATOMIC_RELAXED, __HIP_MEMORY_SCOPE_AGENT); }
__device__ __forceinline__ unsigned xb_add(unsigned* p, unsigned v) { return __hip_atomic_fetch_add(p, v, __ATOMIC_RELAXED, __HIP_MEMORY_SCOPE_AGENT); }
__device__ __forceinline__ unsigned xb_xcc_id() { return (unsigned)__builtin_amdgcn_s_getreg((3 << 11) | 20) & 0xFu; }
#define XB_SPIN(cond, bar) do { unsigned _sp = 0; while (cond) { __builtin_amdgcn_s_sleep(1); \
    if ((++_sp & 255u) == 0u) { if (xb_ld(&(bar)[XB_TMO])) break; if (_sp > XB_SPIN_CAP) { atomicAdd(&(bar)[XB_TMO], 1u); break; } } } } while (0)
struct XcdBarrier { unsigned* bar; unsigned x; volatile LAS unsigned* st; };
__device__ __forceinline__ XcdBarrier xcd_barrier_post(unsigned* bar, volatile LAS unsigned* st) {
    XcdBarrier b; b.bar = bar; b.x = xb_xcc_id(); b.st = st;
    if (threadIdx.x == 0) (void)xb_add(&bar[XB_XCNT(b.x)], 1u);
    return b;
}
__device__ __forceinline__ void xcd_barrier_complete(unsigned* bar, unsigned x, unsigned& nloc, unsigned& nx) {
    const unsigned G = gridDim.x * gridDim.y * gridDim.z;
    unsigned sum, cnt, mine, sp = 0u;
    for (;;) {
        sum = 0u; cnt = 0u; mine = 0u;
#pragma unroll
        for (unsigned j = 0; j < 16; ++j) { const unsigned c = xb_ld(&bar[XB_XCNT(j)]); sum += c; cnt += (c > 0u) ? 1u : 0u; mine = (j == x) ? c : mine; }
        if (sum == G) break;
        __builtin_amdgcn_s_sleep(1);
        if ((++sp & 255u) == 0u) { if (xb_ld(&bar[XB_TMO])) break; if (sp > XB_SPIN_CAP) { atomicAdd(&bar[XB_TMO], 1u); break; } }
    }
    nloc = mine > 0u ? mine : 1u; nx = cnt > 0u ? cnt : 1u;
}
__device__ __forceinline__ void xcd_barrier(const XcdBarrier& b) {
    asm volatile("s_waitcnt vmcnt(0)" ::: "memory");
    __syncthreads();
    if (threadIdx.x == 0) {
        unsigned* bar = b.bar;
        __builtin_amdgcn_s_waitcnt(0);
        unsigned nloc = b.st[0], nx = b.st[1];
        if (nloc == 0u) { xcd_barrier_complete(bar, b.x, nloc, nx); b.st[0] = nloc; b.st[1] = nx; }
        const unsigned old = xb_add(&bar[XB_XSUB(b.x)], 1u);
        const unsigned gen = old / nloc;
        if (old + 1u == (gen + 1u) * nloc) {
            __builtin_amdgcn_fence(__ATOMIC_RELEASE, "agent");
            asm volatile("s_waitcnt vmcnt(0)" ::: "memory");
            const unsigned og = xb_add(&bar[XB_TOP], 1u);
            const unsigned tg = og / nx;
            if (og + 1u == (tg + 1u) * nx) xb_add(&bar[XB_TOPGEN], 1u);
            else XB_SPIN(xb_ld(&bar[XB_TOPGEN]) == tg, bar);
            __builtin_amdgcn_fence(__ATOMIC_ACQUIRE, "agent");
            xb_add(&bar[XB_XGEN(b.x)], 1u);
            asm volatile("s_waitcnt vmcnt(0)" ::: "memory");
        } else {
            XB_SPIN(xb_ld(&bar[XB_XGEN(b.x)]) == gen, bar);
            __builtin_amdgcn_fence(__ATOMIC_ACQUIRE, "agent");
            asm volatile("s_waitcnt vmcnt(0)" ::: "memory");
        }
    }
    __syncthreads();
}

#define LDS_WAIT() asm volatile("s_waitcnt lgkmcnt(0)" ::: "memory")
__device__ __forceinline__ void p0_transpose_item(const float* W, int K, int N, bf16_t* WT, int k0, int n0, int drow0, LAS float* scr, int lane) {
#pragma unroll 8
    for (int i = 0; i < 32; ++i) { const int kk = 2 * i + (lane >> 5); scr[kk * 33 + (lane & 31)] = W[(size_t)(k0 + kk) * N + n0 + (lane & 31)]; }
    LDS_WAIT(); asm volatile("" ::: "memory");
    const int c = lane & 7;
#pragma unroll
    for (int j = 0; j < 4; ++j) { const int n = (lane >> 3) + 8 * j; const LAS float* s = scr + (8 * c) * 33 + n;
        u32x4 o; o.x = pk2(s[0 * 33], s[1 * 33]); o.y = pk2(s[2 * 33], s[3 * 33]); o.z = pk2(s[4 * 33], s[5 * 33]); o.w = pk2(s[6 * 33], s[7 * 33]);
        *(u32x4*)(WT + (size_t)(drow0 + n) * K + k0 + 8 * c) = o; }
    LDS_WAIT(); asm volatile("" ::: "memory");
}

__device__ __forceinline__ float wave_sum(float v) {
#pragma unroll
    for (int o = 1; o < 64; o <<= 1) v += __shfl_xor(v, o);
    return v;
}
__device__ __forceinline__ int build_moe_table(LAS unsigned char* lds, const int* counts, int tid, int lane) {
    LAS int* tab = (LAS int*)(lds + TAB_OFF); LAS int* pstart = tab + 384; LAS int* cntl = pstart + 64; LAS int* ntot = cntl + 64;
    __syncthreads();
    if (tid < 64) {
        const int c = counts[tid]; const int nt = (c + 255) >> 8; int xs = nt;
#pragma unroll
        for (int o = 1; o < 64; o <<= 1) { const int v = __shfl_up(xs, o); if (lane >= o) xs += v; }
        const int ts = xs - nt;
        for (int j = 0; j < nt; ++j) tab[ts + j] = tid | (j << 8);
        pstart[tid] = ts * 256; cntl[tid] = c;
        if (tid == 63) ntot[0] = xs;
    }
    __syncthreads();
    const int NTr = ntot[0];
    if (tid >= 64 && tid < 96) tab[NTr + (tid - 64)] = 64 | ((tid - 64) << 8);
    __syncthreads();
    return NTr + NTOK / 256;
}
__device__ __forceinline__ void attn_item(int i, const bf16_t* q, const bf16_t* k, const bf16_t* v, const float* sinks, bf16_t* out) {
    const int hq = i % NQH, row = i / NQH, b = row / SEQ, t = row % SEQ, hk = hq / (NQH / NKVH);
    float qr[HD], o[HD];
#pragma unroll
    for (int d = 0; d < HD; ++d) { qr[d] = bf2f(q[(size_t)row * ATTN_W + hq * HD + d]); o[d] = 0.f; }
    float m = sinks[hq], l = 1.f;
    const int s0 = (t - (WINDOW - 1)) > 0 ? (t - (WINDOW - 1)) : 0;
    for (int s = s0; s <= t; ++s) {
        const bf16_t* kr = k + (size_t)(b * SEQ + s) * KV_W + hk * HD;
        const bf16_t* vr = v + (size_t)(b * SEQ + s) * KV_W + hk * HD;
        float sc = 0.f;
#pragma unroll
        for (int d = 0; d < HD; ++d) sc += qr[d] * bf2f(kr[d]);
        sc *= 0.125f;
        const float mn = fmaxf(m, sc), f = expf(m - mn), p = expf(sc - mn);
        l = l * f + p; m = mn;
#pragma unroll
        for (int d = 0; d < HD; ++d) o[d] = o[d] * f + p * bf2f(vr[d]);
    }
    const float inv = 1.f / l;
#pragma unroll
    for (int d = 0; d < HD; ++d) out[(size_t)row * ATTN_W + hq * HD + d] = f2bf(o[d] * inv);
}
__device__ __forceinline__ void sgu_unit(int unit, LAS unsigned char* lds, const bf16_t* vgg, const bf16_t* u, const float* lng, const float* lnb, const float* wsp, const float* bsp, bf16_t* out, int tid) {
    LAS float* vn = (LAS float*)lds;
    const int g = unit & 7, bc = unit >> 3;
    const int rowbase = bc * CHUNK;
    {
        const int r = tid >> 2, qd = tid & 3;
        const bf16_t* p = vgg + (size_t)(rowbase + r) * SGU_W + g * SGU_C + qd * 32;
        float f[32];
#pragma unroll
        for (int j = 0; j < 4; ++j) { float t8[8]; pg8::unpack8(*(const u32x4*)(p + 8 * j), t8);
#pragma unroll
            for (int e = 0; e < 8; ++e) f[8 * j + e] = t8[e]; }
        float s = 0.f;
#pragma unroll
        for (int j = 0; j < 32; ++j) s += f[j];
        s += __shfl_xor(s, 1); s += __shfl_xor(s, 2);
        const float mu = s * (1.f / SGU_C); float qq = 0.f;
#pragma unroll
        for (int j = 0; j < 32; ++j) { const float d = f[j] - mu; qq += d * d; }
        qq += __shfl_xor(qq, 1); qq += __shfl_xor(qq, 2);
        const float rstd = 1.f / sqrtf(qq * (1.f / SGU_C) + LN_EPS);
#pragma unroll
        for (int j = 0; j < 32; ++j) { const int c = qd * 32 + j; vn[r * 128 + c] = (f[j] - mu) * rstd * lng[g * SGU_C + c] + lnb[g * SGU_C + c]; }
    }
    __syncthreads();
    {
        const int c = tid & 127, tg = __builtin_amdgcn_readfirstlane(tid >> 7);
        for (int i = 0; i < 8; ++i) {
            const int tb = tg + 4 * i;
            const float* w0 = wsp + ((size_t)g * CHUNK + 4 * tb) * CHUNK;
            float acc[4] = {0.f, 0.f, 0.f, 0.f};
            for (int s4 = 0; s4 <= tb; ++s4) {
                float v4[4];
#pragma unroll
                for (int ss = 0; ss < 4; ++ss) v4[ss] = vn[(4 * s4 + ss) * 128 + c];
#pragma unroll
                for (int tt = 0; tt < 4; ++tt) {
                    const f32x4 wr4 = *(const f32x4*)(w0 + tt * CHUNK + 4 * s4);
#pragma unroll
                    for (int ss = 0; ss < 4; ++ss) { const float wv = (s4 < tb || ss <= tt) ? wr4[ss] : 0.f; acc[tt] += wv * v4[ss]; }
                }
            }
#pragma unroll
            for (int tt = 0; tt < 4; ++tt) { const int t = 4 * tb + tt; const size_t o = (size_t)(rowbase + t) * SGU_W + g * SGU_C + c;
                out[o] = f2bf(bf2f(u[o]) * (acc[tt] + bsp[g * CHUNK + t])); }
        }
    }
    __syncthreads();
}
__device__ __forceinline__ void route_row(int t, float logit, const float* rbias, int* counts, int* tokl, int* slot_e, int* slot_p, float* slot_w, int lane) {
    const float score = sigmoidf_(logit);
    const float biased = score + rbias[lane];
    const int grp = lane >> 3;
    float m1 = biased;
#pragma unroll
    for (int o = 1; o < 8; o <<= 1) m1 = fmaxf(m1, __shfl_xor(m1, o));
    const unsigned long long eq = __ballot(biased == m1) & (0xFFull << (grp * 8));
    const int first = __ffsll((long long)eq) - 1;
    float m2 = (lane == first) ? -INFINITY : biased;
#pragma unroll
    for (int o = 1; o < 8; o <<= 1) m2 = fmaxf(m2, __shfl_xor(m2, o));
    const float gs = m1 + m2;
    int grank = 0;
#pragma unroll
    for (int g2 = 0; g2 < NGRP; ++g2) { const float o = __shfl(gs, g2 * 8); grank += (o > gs || (o == gs && g2 < grp)) ? 1 : 0; }
    const bool gsel = grank < TOPKG;
    const float masked = gsel ? biased : -INFINITY;
    int rank = 0;
    for (int e2 = 0; e2 < NE; ++e2) { const float o = __shfl(masked, e2); rank += (o > masked || (o == masked && e2 < lane)) ? 1 : 0; }
    const bool sel = gsel && rank < TOPK;
    const float wsum = wave_sum(sel ? score : 0.f);
    const unsigned long long sb = __ballot(sel);
    if (sel) {
        const int kidx = __popcll(sb & ((1ull << lane) - 1ull));
        const int pos = atomicAdd(&counts[lane], 1);
        tokl[(size_t)lane * 8192 + pos] = t;
        slot_e[t * TOPK + kidx] = lane; slot_p[t * TOPK + kidx] = pos; slot_w[t * TOPK + kidx] = score / (wsum + 1e-20f) * ROUTED_SCALE;
    }
}

struct Args { const float* in[23]; float* out; unsigned char* ws; int ph_lo, ph_hi, li, pad; };

__global__ void __launch_bounds__(NWAVES * 64, 2) mk_fwd(Args args) {
    extern __shared__ __attribute__((aligned(16))) unsigned char lds_raw[];
    LAS unsigned char* lds = (LAS unsigned char*)lds_raw;
    volatile LAS unsigned* MISC = (volatile LAS unsigned*)(lds + MISC_OFF);
    const int tid = threadIdx.x, lane = tid & 63, wave = __builtin_amdgcn_readfirstlane(tid >> 6);
    const int G = gridDim.x; const int bx = blockIdx.x; const int vcu = (G % 8 == 0) ? (bx % 8) * (G / 8) + bx / 8 : bx;
    unsigned char* ws = args.ws;
    unsigned* ctl = (unsigned*)(ws + WS_CTL);
    for (int u = tid; u < (LDS_BYTES - LDSCTL_OFF) / 4; u += NWAVES * 64) ((LAS unsigned*)(lds + LDSCTL_OFF))[u] = 0u;
    __syncthreads();
    XcdBarrier bar = xcd_barrier_post(ctl + CW_BAR + args.li * XCD_BAR_WORDS, MISC + 8);
    const int lo = args.ph_lo, hi = args.ph_hi;
#define IN(k) (lo <= (k) && (k) < hi)
#define BOTH(k) (IN(k) && IN((k) + 1))

    if (IN(0)) {
        LAS float* scr = (LAS float*)(lds + RING_OFF + wave * 16384);
        const int gw = vcu * NWAVES + wave, NGW = G * NWAVES;
        const float* w_in = args.in[1]; const float* wA = args.in[8]; const float* wB = args.in[9]; const float* wo = args.in[10];
        const float* w1 = args.in[15]; const float* w3 = args.in[16]; const float* w2 = args.in[17]; const float* ws1 = args.in[18]; const float* ws3 = args.in[19]; const float* ws2 = args.in[20];
        bf16_t* WtIn = (bf16_t*)(ws + WS_WTIN); bf16_t* WtA = (bf16_t*)(ws + WS_WTA); bf16_t* WtB = (bf16_t*)(ws + WS_WTB); bf16_t* WtO = (bf16_t*)(ws + WS_WTO);
        bf16_t* Wt13 = (bf16_t*)(ws + WS_WT13); bf16_t* Wt2 = (bf16_t*)(ws + WS_WT2); bf16_t* WtS13 = (bf16_t*)(ws + WS_WTS13); bf16_t* WtS2 = (bf16_t*)(ws + WS_WTS2);
        constexpr int I_IN = (D_MODEL / 64) * (IN_W / 32), I_A = (ATTN_W / 64) * (D_MODEL / 32), I_B = (SGU_W / 64) * (D_MODEL / 32), I_O = (D_MODEL / 64) * (D_MODEL / 32);
        constexpr int I_E1 = (D_MODEL / 64) * (DE / 32);
        constexpr int I_E2 = (DE / 64) * (D_MODEL / 32);
        constexpr int I_W1 = NE * I_E1, I_W2 = NE * I_E2;
        constexpr int NITEMS = I_IN + I_A + I_B + I_O + 2 * I_W1 + I_W2 + 2 * I_E1 + I_E2;
        for (int it = gw; it < NITEMS; it += NGW) {
            int r = it;
            if (r < I_IN) { const int nb = IN_W / 32; p0_transpose_item(w_in, D_MODEL, IN_W, WtIn, 64 * (r / nb), 32 * (r % nb), 32 * (r % nb), scr, lane); continue; } r -= I_IN;
            if (r < I_A) { const int nb = D_MODEL / 32; p0_transpose_item(wA, ATTN_W, D_MODEL, WtA, 64 * (r / nb), 32 * (r % nb), 32 * (r % nb), scr, lane); continue; } r -= I_A;
            if (r < I_B) { const int nb = D_MODEL / 32; p0_transpose_item(wB, SGU_W, D_MODEL, WtB, 64 * (r / nb), 32 * (r % nb), 32 * (r % nb), scr, lane); continue; } r -= I_B;
            if (r < I_O) { const int nb = D_MODEL / 32; p0_transpose_item(wo, D_MODEL, D_MODEL, WtO, 64 * (r / nb), 32 * (r % nb), 32 * (r % nb), scr, lane); continue; } r -= I_O;
            if (r < 2 * I_W1) {
                const int which = r / I_W1; const int rr = r % I_W1; const int e = rr / I_E1, q = rr % I_E1; const int nb = DE / 32; const int k0 = 64 * (q / nb), n0 = 32 * (q % nb);
                const float* src = (which ? w3 : w1) + (size_t)e * D_MODEL * DE;
                p0_transpose_item(src, D_MODEL, DE, Wt13 + (size_t)e * 1024 * D_MODEL, k0, n0, (n0 / 128) * 256 + (n0 % 128) + which * 128, scr, lane); continue; } r -= 2 * I_W1;
            if (r < I_W2) { const int e = r / I_E2, q = r % I_E2; const int nb = D_MODEL / 32; const int k0 = 64 * (q / nb), n0 = 32 * (q % nb);
                p0_transpose_item(w2 + (size_t)e * DE * D_MODEL, DE, D_MODEL, Wt2 + (size_t)e * D_MODEL * DE, k0, n0, n0, scr, lane); continue; } r -= I_W2;
            if (r < 2 * I_E1) { const int which = r / I_E1, q = r % I_E1; const int nb = DS / 32; const int k0 = 64 * (q / nb), n0 = 32 * (q % nb);
                p0_transpose_item(which ? ws3 : ws1, D_MODEL, DS, WtS13, k0, n0, (n0 / 128) * 256 + (n0 % 128) + which * 128, scr, lane); continue; } r -= 2 * I_E1;
            { const int nb = D_MODEL / 32; p0_transpose_item(ws2, DS, D_MODEL, WtS2, 64 * (r / nb), 32 * (r % nb), 32 * (r % nb), scr, lane); }
        }
        { const float* x = args.in[0]; bf16_t* xb = (bf16_t*)(ws + WS_XB); const size_t n8 = (size_t)NTOK * D_MODEL / 8;
          for (size_t i = (size_t)vcu * 512 + tid; i < n8; i += (size_t)G * 512) { const f32x4 a = *(const f32x4*)(x + 8 * i), b = *(const f32x4*)(x + 8 * i + 4);
              u32x4 o; o.x = pk2(a[0], a[1]); o.y = pk2(a[2], a[3]); o.z = pk2(b[0], b[1]); o.w = pk2(b[2], b[3]); *(u32x4*)(xb + 8 * i) = o; } }
        { float* tab = (float*)(ws + WS_ROPE);
          for (int i = vcu * 512 + tid; i < SEQ * 8; i += G * 512) { const int pos = i >> 3, f = i & 7; const float invf = (float)pow(500000.0, -(double)f / 8.0); const float ang = (float)pos * invf;
              tab[2 * i] = (float)cos((double)ang); tab[2 * i + 1] = (float)sin((double)ang); } }
        { bf16_t* y1b = (bf16_t*)(ws + WS_Y1B); for (int i = vcu * 512 + tid; i < D_MODEL; i += G * 512) y1b[(size_t)NTOK * D_MODEL + i] = 0; }
        if (BOTH(0)) xcd_barrier(bar);
    }

    if (IN(1)) {
        pg8::DenseSched S; S.o.init(NTOK / 256, IN_W / 256, G, bx); S.A = (const char*)(ws + WS_XB); S.Bt = (const char*)(ws + WS_WTIN); S.K = D_MODEL;
        pg8::EpiIn E{args.in[2], (const float*)(ws + WS_ROPE), (bf16_t*)(ws + WS_Q), (bf16_t*)(ws + WS_K), (bf16_t*)(ws + WS_V), (bf16_t*)(ws + WS_U), (bf16_t*)(ws + WS_VGG), (bf16_t*)(ws + WS_GA), (bf16_t*)(ws + WS_GB)};
        pg8::gemm_phase<pg8::EpiIn, pg8::DenseSched>(lds + RING_OFF, S, E);
        if (BOTH(1)) xcd_barrier(bar);
    }

    if (IN(2)) {
        const bf16_t* q = (const bf16_t*)(ws + WS_Q); const bf16_t* k = (const bf16_t*)(ws + WS_K); const bf16_t* v = (const bf16_t*)(ws + WS_V);
        for (int i = vcu * 512 + tid; i < NTOK * NQH; i += G * 512) attn_item(i, q, k, v, args.in[3], (bf16_t*)(ws + WS_ATTN));
        for (int un = vcu; un < BATCH * (SEQ / CHUNK) * SGU_G; un += G)
            sgu_unit(un, lds, (const bf16_t*)(ws + WS_VGG), (const bf16_t*)(ws + WS_U), args.in[4], args.in[5], args.in[6], args.in[7], (bf16_t*)(ws + WS_SGU), tid);
        if (BOTH(2)) xcd_barrier(bar);
    }
    if (IN(3)) {
        pg8::MergeSched S; S.o.init(NTOK / 256, D_MODEL / 256, G, bx); S.attn = (const char*)(ws + WS_ATTN); S.sgu = (const char*)(ws + WS_SGU); S.WtA = (const char*)(ws + WS_WTA); S.WtB = (const char*)(ws + WS_WTB);
        pg8::EpiMerge E{(const bf16_t*)(ws + WS_GA), (const bf16_t*)(ws + WS_GB), (bf16_t*)(ws + WS_MERGED)};
        pg8::gemm_phase<pg8::EpiMerge, pg8::MergeSched>(lds + RING_OFF, S, E);
        if (BOTH(3)) xcd_barrier(bar);
    }
    if (IN(4)) {
        pg8::DenseSched S; S.o.init(NTOK / 256, D_MODEL / 256, G, bx); S.A = (const char*)(ws + WS_MERGED); S.Bt = (const char*)(ws + WS_WTO); S.K = D_MODEL;
        pg8::EpiWo E{args.in[0], (float*)(ws + WS_Y1PRE)};
        pg8::gemm_phase<pg8::EpiWo, pg8::DenseSched>(lds + RING_OFF, S, E);
        if (BOTH(4)) xcd_barrier(bar);
    }
    if (IN(5)) {
        const float* y1pre = (const float*)(ws + WS_Y1PRE); float* y1 = (float*)(ws + WS_Y1); bf16_t* y1b = (bf16_t*)(ws + WS_Y1B);
        const float* g1 = args.in[11]; const float* b1 = args.in[12]; const float* wr = args.in[13];
        LAS float* yn = (LAS float*)lds;
        for (int tile = vcu; tile < NTOK / 16; tile += G) {
            const int r0 = tile * 16;
#pragma unroll 1
            for (int rr = 0; rr < 2; ++rr) {
                const int r = wave * 2 + rr; const size_t ro = (size_t)(r0 + r) * D_MODEL;
                f32x4 v[8]; float s = 0.f;
#pragma unroll
                for (int j = 0; j < 8; ++j) { v[j] = *(const f32x4*)(y1pre + ro + lane * 4 + 256 * j); s += (v[j][0] + v[j][1]) + (v[j][2] + v[j][3]); }
                const float mu = wave_sum(s) * (1.f / D_MODEL); float qq = 0.f;
#pragma unroll
                for (int j = 0; j < 8; ++j) { v[j] = v[j] - mu; qq += (v[j][0] * v[j][0] + v[j][1] * v[j][1]) + (v[j][2] * v[j][2] + v[j][3] * v[j][3]); }
                const float rstd = 1.f / sqrtf(wave_sum(qq) * (1.f / D_MODEL) + LN_EPS);
#pragma unroll
                for (int j = 0; j < 8; ++j) { const int c = lane * 4 + 256 * j; const f32x4 o = v[j] * rstd * *(const f32x4*)(g1 + c) + *(const f32x4*)(b1 + c);
                    *(f32x4*)(y1 + ro + c) = o; f32x2 pk; pk[0] = __uint_as_float(pk2(o[0], o[1])); pk[1] = __uint_as_float(pk2(o[2], o[3])); *(f32x2*)(y1b + ro + c) = pk;
                    *(LAS f32x4*)(yn + r * D_MODEL + c) = o; }
            }
            __syncthreads();
            float acc[16];
#pragma unroll
            for (int r = 0; r < 16; ++r) acc[r] = 0.f;
            for (int d = wave * 256; d < wave * 256 + 256; d += 4) {
                float wv[4];
#pragma unroll
                for (int i = 0; i < 4; ++i) wv[i] = wr[(size_t)(d + i) * NE + lane];
#pragma unroll
                for (int r = 0; r < 16; ++r) { const f32x4 y4 = *(const LAS f32x4*)(yn + r * D_MODEL + d); acc[r] += (y4[0] * wv[0] + y4[1] * wv[1]) + (y4[2] * wv[2] + y4[3] * wv[3]); }
            }
            __syncthreads();
#pragma unroll
            for (int r = 0; r < 16; ++r) yn[(wave * 16 + r) * NE + lane] = acc[r];
            __syncthreads();
#pragma unroll 1
            for (int rr = 0; rr < 2; ++rr) {
                const int r = wave * 2 + rr; float lg = 0.f;
#pragma unroll
                for (int w2 = 0; w2 < 8; ++w2) lg += yn[(w2 * 16 + r) * NE + lane];
                route_row(r0 + r, lg, args.in[14], (int*)(ws + WS_CTL), (int*)(ws + WS_TOKL), (int*)(ws + WS_SLOT_E), (int*)(ws + WS_SLOT_P), (float*)(ws + WS_SLOT_W), lane);
            }
            __syncthreads();
        }
        if (BOTH(5)) xcd_barrier(bar);
    }
    if (IN(6) || IN(7)) {
        LAS int* tab = (LAS int*)(lds + TAB_OFF); LAS int* pstart = tab + 384; LAS int* cntl = pstart + 64;
        const int NT = build_moe_table(lds, (const int*)(ws + WS_CTL), tid, lane);
        pg8::MoeSched S; S.tab = tab; S.pstart = pstart; S.cnt = cntl;
        S.y1b = (const char*)(ws + WS_Y1B); S.tokl = (const int*)(ws + WS_TOKL); S.Wt13 = (const char*)(ws + WS_WT13); S.WtS13 = (const char*)(ws + WS_WTS13);
        S.H = (const char*)(ws + WS_H); S.Wt2 = (const char*)(ws + WS_WT2); S.WtS2 = (const char*)(ws + WS_WTS2);
        if (IN(6)) {
            S.mode = 1; S.o.init(NT, 4, G, bx);
            pg8::EpiSwiglu E{(bf16_t*)(ws + WS_H)};
            pg8::gemm_phase<pg8::EpiSwiglu, pg8::MoeSched>(lds + RING_OFF, S, E);
            if (BOTH(6)) xcd_barrier(bar);
        }
        if (IN(7)) {
            S.mode = 2; S.o.init(NT, 8, G, bx);
            pg8::EpiOut E{(bf16_t*)(ws + WS_OUT)};
            pg8::gemm_phase<pg8::EpiOut, pg8::MoeSched>(lds + RING_OFF, S, E);
            if (BOTH(7)) xcd_barrier(bar);
        }
    }

    if (IN(8)) {
        (void)build_moe_table(lds, (const int*)(ws + WS_CTL), tid, lane);
        const LAS int* pstart = (const LAS int*)(lds + TAB_OFF) + 384;
        const float* y1 = (const float*)(ws + WS_Y1); const bf16_t* OUTB = (const bf16_t*)(ws + WS_OUT); const bf16_t* shout = OUTB + (size_t)SLOT_ROWS * D_MODEL;
        const int* slot_e = (const int*)(ws + WS_SLOT_E); const int* slot_p = (const int*)(ws + WS_SLOT_P); const float* slot_w = (const float*)(ws + WS_SLOT_W);
        const float* g2 = args.in[21]; const float* b2 = args.in[22];
        for (int row = vcu * NWAVES + wave; row < NTOK; row += G * NWAVES) {
            const size_t ro = (size_t)row * D_MODEL;
            f32x4 v[8];
#pragma unroll
            for (int j = 0; j < 8; ++j) { const int c = lane * 4 + 256 * j; const f32x2 sh = *(const f32x2*)(shout + ro + c); const unsigned s0 = __float_as_uint(sh[0]), s1 = __float_as_uint(sh[1]);
                v[j] = *(const f32x4*)(y1 + ro + c) * ALPHA + (f32x4){__uint_as_float(s0 << 16), __uint_as_float(s0 & 0xffff0000u), __uint_as_float(s1 << 16), __uint_as_float(s1 & 0xffff0000u)}; }
#pragma unroll 1
            for (int kk = 0; kk < TOPK; ++kk) {
                const int e = __builtin_amdgcn_readfirstlane(slot_e[row * TOPK + kk]), p = __builtin_amdgcn_readfirstlane(slot_p[row * TOPK + kk]); const float w = slot_w[row * TOPK + kk];
                const bf16_t* srcp = OUTB + (size_t)(pstart[e] + p) * D_MODEL;
#pragma unroll
                for (int j = 0; j < 8; ++j) { const int c = lane * 4 + 256 * j; const f32x2 sh = *(const f32x2*)(srcp + c); const unsigned s0 = __float_as_uint(sh[0]), s1 = __float_as_uint(sh[1]);
                    v[j] = v[j] + (f32x4){__uint_as_float(s0 << 16), __uint_as_float(s0 & 0xffff0000u), __uint_as_float(s1 << 16), __uint_as_float(s1 & 0xffff0000u)} * w; }
            }
            float s = 0.f;
#pragma unroll
            for (int j = 0; j < 8; ++j) s += (v[j][0] + v[j][1]) + (v[j][2] + v[j][3]);
            const float mu = wave_sum(s) * (1.f / D_MODEL); float qq = 0.f;
#pragma unroll
            for (int j = 0; j < 8; ++j) { v[j] = v[j] - mu; qq += (v[j][0] * v[j][0] + v[j][1] * v[j][1]) + (v[j][2] * v[j][2] + v[j][3] * v[j][3]); }
            const float rstd = 1.f / sqrtf(wave_sum(qq) * (1.f / D_MODEL) + LN_EPS);
#pragma unroll
            for (int j = 0; j < 8; ++j) { const int c = lane * 4 + 256 * j; *(f32x4*)(args.out + ro + c) = v[j] * rstd * *(const f32x4*)(g2 + c) + *(const f32x4*)(b2 + c); }
        }
    }
#undef IN
#undef BOTH
}

extern "C" void kernel_launch(void* const* d_in, const int* in_sizes, int n_in, void* d_out, int out_size, void* d_ws, size_t ws_size, hipStream_t stream) {
    static int grid = 0;
    if (grid == 0) {
        if (n_in != 23 || ws_size < WS_END) { fprintf(stderr, "kernel_launch: unexpected n_in %d / ws %zu (need %zu)\n", n_in, ws_size, (size_t)WS_END); grid = -1; return; }
        int dev = 0, cus = 0;
        if (hipGetDevice(&dev) != hipSuccess || hipDeviceGetAttribute(&cus, hipDeviceAttributeMultiprocessorCount, dev) != hipSuccess) { grid = -1; return; }
        if (hipFuncSetAttribute((const void*)mk_fwd, hipFuncAttributeMaxDynamicSharedMemorySize, LDS_BYTES) != hipSuccess) { fprintf(stderr, "kernel_launch: hipFuncSetAttribute failed\n"); grid = -1; return; }
        (void)hipGetLastError();
        grid = cus;
    }
    if (grid < 0) return;
    char* ws = (char*)d_ws;
    if (hipMemsetAsync(ws + WS_CTL, 0, CTL_ZERO_BYTES, stream) != hipSuccess) { fprintf(stderr, "kernel_launch: memset failed\n"); return; }
    Args a{};
    for (int i = 0; i < 23; ++i) a.in[i] = (const float*)d_in[i];
    a.out = (float*)d_out; a.ws = (unsigned char*)d_ws; a.ph_lo = 0; a.ph_hi = 9; a.li = 0;
    hipLaunchKernelGGL(mk_fwd, dim3(grid), dim3(NWAVES * 64), LDS_BYTES, stream, a);
}
```

```cpp
#include <hip/hip_runtime.h>
#include <cstdio>
#include <cstdint>
#include <cmath>

typedef unsigned short bf16_t;
typedef float f32x4 __attribute__((ext_vector_type(4)));
typedef float f32x2 __attribute__((ext_vector_type(2)));
typedef unsigned u32x4 __attribute__((ext_vector_type(4)));
typedef short bf16x8 __attribute__((ext_vector_type(8)));
#define LAS __attribute__((address_space(3)))
#define GAS __attribute__((address_space(1)))

constexpr int D_MODEL = 2048, BATCH = 2, SEQ = 4096, NTOK = BATCH * SEQ;
constexpr int NQH = 32, NKVH = 4, HD = 64, WINDOW = 128, ROT = 16;
constexpr int SGU_G = 8, SGU_C = 128, CHUNK = 128;
constexpr int NE = 64, NGRP = 8, TOPKG = 4, TOPK = 8, DE = 512, DS = 512;
constexpr int ATTN_W = 2048, KV_W = 256, SGU_W = 1024, IN_W = 8704;
constexpr float ROUTED_SCALE = 2.5f;
constexpr float LN_EPS = 1e-5f;
constexpr float ALPHA = 1.189207115002721f;
constexpr int OFF_Q = 0, OFF_K = 2048, OFF_V = 2304, OFF_U = 2560, OFF_VG = 3584, OFF_GA = 4608, OFF_GB = 6656;
constexpr int ZERO_ROW = NTOK;

__device__ __forceinline__ float bf2f(bf16_t b) { return __uint_as_float(((unsigned)b) << 16); }
__device__ __forceinline__ bf16_t f2bf(float f) { unsigned u = __float_as_uint(f); return (bf16_t)((u + 0x7fffu + ((u >> 16) & 1u)) >> 16); }
__device__ __forceinline__ unsigned pk2(float lo, float hi) { return (unsigned)f2bf(lo) | ((unsigned)f2bf(hi) << 16); }
__device__ __forceinline__ float ldf(const float* p) { return *p; }
__device__ __forceinline__ float ldf(const bf16_t* p) { return bf2f(*p); }
__device__ __forceinline__ float gelu_tanh(float x) { const float c = 0.7978845608028654f; float t = tanhf(c * (x + 0.044715f * x * x * x)); return 0.5f * x * (1.f + t); }
__device__ __forceinline__ float sigmoidf_(float x) { return 1.f / (1.f + expf(-x)); }
__device__ __forceinline__ float fsigmoid(float x) { return __builtin_amdgcn_rcpf(1.f + __expf(-x)); }
__device__ __forceinline__ float fgelu(float x) { const float z2 = 1.5957691216057308f * (x + 0.044715f * x * x * x); return x * fsigmoid(z2); }

constexpr size_t MiB = 1u << 20;
constexpr size_t WS_CTL = 0, CTL_ZERO_BYTES = 1 * MiB;
constexpr size_t WS_SLOT_E = 1 * MiB, WS_SLOT_P = 1 * MiB + 256 * 1024, WS_SLOT_W = 1 * MiB + 512 * 1024;
constexpr size_t WS_TOKL = 2 * MiB;
constexpr size_t WS_ROPE = 4 * MiB;
constexpr size_t WS_WT13 = 6 * MiB;
constexpr size_t WS_WT2 = 262 * MiB;
constexpr size_t WS_WTS13 = 390 * MiB;
constexpr size_t WS_WTS2 = 394 * MiB;
constexpr size_t WS_Y1 = 396 * MiB;
constexpr size_t WS_Y1B = 460 * MiB;
constexpr size_t WS_H = 494 * MiB;
constexpr size_t WS_OUT = 582 * MiB;
constexpr size_t WS_WTIN = 582 * MiB;
constexpr size_t WS_XB = 616 * MiB;
constexpr size_t WS_Q = 648 * MiB, WS_K = 680 * MiB, WS_V = 684 * MiB, WS_U = 688 * MiB, WS_VGG = 704 * MiB, WS_GA = 720 * MiB, WS_GB = 752 * MiB;
constexpr size_t WS_ATTN = 784 * MiB, WS_SGU = 816 * MiB, WS_MERGED = 832 * MiB;
constexpr size_t WS_WTA = 864 * MiB, WS_WTB = 872 * MiB, WS_WTO = 876 * MiB;
constexpr size_t WS_Y1PRE = 934 * MiB;
constexpr size_t WS_END = 998 * MiB;
constexpr size_t WS_TA = 494 * MiB, WS_TB = 558 * MiB, WS_VN = 934 * MiB, WS_LOGIT = 966 * MiB;
constexpr int SLOT_ROWS = 81920;

namespace pg8 {
constexpr int BM = 256, BK = 64, HALF = 128, HTB = HALF * BK * 2, STAGE_BYTES = 8 * HTB, NXCD = 8, WGM = 8;
__host__ __device__ __forceinline__ int lds_byte(int r, int c) { const int st = (r >> 4) * 2 + (c >> 5), rr = r & 15, cc = c & 31, ob = rr * 64 + cc * 2; return st * 1024 + (ob ^ (((ob >> 9) & 1) << 5)); }
__host__ __device__ __forceinline__ void stage_rc(int b, int& R, int& C) { const int st = b / 1024, sb = b % 1024, swz = sb ^ (((sb >> 9) & 1) << 5); R = (st >> 1) * 16 + swz / 64; C = (st & 1) * 32 + (swz % 64) / 2; }
__host__ __device__ __forceinline__ int perm32(int rho) { const int n = rho >> 4, i = rho & 15; return 8 * (i >> 2) + 4 * n + (i & 3); }

struct Unit {
    const char* A;
    const char* B;
    const int* gl;
    int gcnt, K;
    int pm, pn, aux;
    int chain;
};

__device__ __forceinline__ unsigned cvt_pk_bf16(float lo, float hi) { unsigned r; asm volatile("v_cvt_pk_bf16_f32 %0, %1, %2" : "=v"(r) : "v"(lo), "v"(hi)); return r; }

__device__ __forceinline__ void unit_offsets(const Unit& u, const int (&R)[2], const int (&C)[2], const int (&Rb)[2], unsigned (&vA)[2][2], unsigned (&vB)[2]) {
#pragma unroll
    for (int i = 0; i < 2; ++i) {
        vB[i] = (unsigned)(Rb[i] * u.K + C[i]) * 2u;
#pragma unroll
        for (int h = 0; h < 2; ++h) {
            int row = R[i] + HALF * h;
            if (u.gl) row = (row < u.gcnt) ? u.gl[row] : ZERO_ROW;
            vA[h][i] = (unsigned)(row * u.K + C[i]) * 2u;
        }
    }
    if (u.gl) asm volatile("" :: "v"(vA[0][0]), "v"(vA[0][1]), "v"(vA[1][0]), "v"(vA[1][1]));
}

template <class Epi, class Sched>
__device__ __forceinline__ void gemm_phase(LAS unsigned char* lds, const Sched& S, const Epi& E) {
    const int tid = threadIdx.x, wid = __builtin_amdgcn_readfirstlane(tid >> 6), lane = tid & 63, wr = wid >> 2, wc = wid & 3, fr = lane & 15, fq = lane >> 4;
    int R[2], C[2], Rb[2];
#pragma unroll
    for (int i = 0; i < 2; ++i) { stage_rc(tid * 16 + i * 8192, R[i], C[i]); Rb[i] = Epi::PERM ? ((R[i] & ~31) + perm32(R[i] & 31)) : R[i]; }
    const size_t kstep = (size_t)(BK * 2);
    const unsigned ldsw = (unsigned)wid * 1024u;
    const int aoff = lds_byte(wr * 64 + fr, fq * 8), boff = lds_byte(wc * 32 + fr, fq * 8);
#define PG8_SA(b, h) (((b) * 2 + (h)) * HTB)
#define PG8_SB(b, h) ((4 + (b) * 2 + (h)) * HTB)
#define PG8_STAGE(bufoff, gbase, voff) do { _Pragma("unroll") for (int _i = 0; _i < 2; ++_i) \
        __builtin_amdgcn_global_load_lds((const unsigned*)((const char*)(gbase) + (voff)[_i]), (LAS unsigned*)(lds + (bufoff) + ldsw + _i * 8192), 16, 0, 0); } while (0)
#define PG8_LDA(dst, b, h) do { _Pragma("unroll") for (int m = 0; m < 4; ++m) _Pragma("unroll") for (int k = 0; k < 2; ++k) dst[m][k] = *(const LAS bf16x8*)(lds + PG8_SA(b, h) + aoff + m * 2048 + k * 1024); } while (0)
#define PG8_LDB(dst, b, h) do { _Pragma("unroll") for (int n = 0; n < 2; ++n) _Pragma("unroll") for (int k = 0; k < 2; ++k) dst[n][k] = *(const LAS bf16x8*)(lds + PG8_SB(b, h) + boff + n * 2048 + k * 1024); } while (0)
#define PG8_MMA(ai, bj, At, Bt) do { __builtin_amdgcn_s_setprio(1); _Pragma("unroll") for (int m = 0; m < 4; ++m) _Pragma("unroll") for (int n = 0; n < 2; ++n) _Pragma("unroll") for (int k = 0; k < 2; ++k) \
        acc[ai][bj][m][n] = __builtin_amdgcn_mfma_f32_16x16x32_bf16(Bt[n][k], At[m][k], acc[ai][bj][m][n], 0, 0, 0); __builtin_amdgcn_s_setprio(0); } while (0)
#define PG8_WAIT_V(n) asm volatile("s_waitcnt vmcnt(" #n ")" ::: "memory")
#define PG8_WAIT_L(n) asm volatile("s_waitcnt lgkmcnt(" #n ")" ::: "memory")
#define PG8_BAR __builtin_amdgcn_s_barrier()
#define PG8_SCHED __builtin_amdgcn_sched_barrier(0)
    Unit cur, nxt; int ui = 0;
    if (!S.next(0, cur)) return;
    f32x4 acc[2][2][4][2];
#pragma unroll
    for (int a = 0; a < 2; ++a)
#pragma unroll
        for (int b = 0; b < 2; ++b)
#pragma unroll
            for (int m = 0; m < 4; ++m)
#pragma unroll
                for (int n = 0; n < 2; ++n) acc[a][b][m][n] = (f32x4){0.f, 0.f, 0.f, 0.f};
    bf16x8 At[4][2], B0[2][2], B1[2][2];
    unsigned cvA[2][2], cvB[2], nvA[2][2], nvB[2];
    unit_offsets(cur, R, C, Rb, cvA, cvB);
    const char* cA = cur.A; const char* cB = cur.B; size_t chs = (size_t)HALF * cur.K * 2;
    PG8_STAGE(PG8_SB(0, 0), cB, cvB); PG8_STAGE(PG8_SB(0, 1), cB + chs, cvB); PG8_STAGE(PG8_SA(0, 0), cA, cvA[0]); PG8_STAGE(PG8_SA(0, 1), cA, cvA[1]);
    if (wr == 1) PG8_BAR;
    PG8_WAIT_V(2); PG8_BAR;
    PG8_STAGE(PG8_SB(1, 0), cB + kstep, cvB); PG8_STAGE(PG8_SA(1, 0), cA + kstep, cvA[0]); PG8_STAGE(PG8_SB(1, 1), cB + chs + kstep, cvB);
    PG8_WAIT_V(6); PG8_BAR;
    for (;;) {
        const bool has_next = S.next(ui + 1, nxt);
        const char* nA = cA; const char* nB = cB; size_t nhs = chs;
        if (has_next) { unit_offsets(nxt, R, C, Rb, nvA, nvB); nA = nxt.A; nB = nxt.B; nhs = (size_t)HALF * nxt.K * 2; }
        else {
#pragma unroll
            for (int i = 0; i < 2; ++i) { nvB[i] = cvB[i]; nvA[0][i] = cvA[0][i]; nvA[1][i] = cvA[1][i]; }
        }
        const int nt = cur.K / BK;
        for (int t = 0; t < nt; t += 2) {
            const bool last = (t == nt - 2);
            const char* a1 = cA + (size_t)(t + 1) * kstep;
            const char* a2 = last ? nA : cA + (size_t)(t + 2) * kstep; const char* b2 = last ? nB : cB + (size_t)(t + 2) * kstep;
            const char* a3 = a2 + kstep; const char* b3 = b2 + kstep;
            const size_t hs2 = last ? nhs : chs;
            unsigned vA2[2][2], vB2[2];
#pragma unroll
            for (int i = 0; i < 2; ++i) { vB2[i] = last ? nvB[i] : cvB[i]; vA2[0][i] = last ? nvA[0][i] : cvA[0][i]; vA2[1][i] = last ? nvA[1][i] : cvA[1][i]; }
            PG8_LDB(B0, 0, 0); PG8_LDB(B1, 0, 1); PG8_SCHED; PG8_LDA(At, 0, 0); PG8_STAGE(PG8_SA(1, 1), a1, cvA[1]);
            PG8_WAIT_V(8); PG8_WAIT_L(0); PG8_BAR; PG8_MMA(0, 0, At, B0); PG8_MMA(0, 1, At, B1); PG8_BAR; PG8_SCHED;
            PG8_LDA(At, 0, 1); PG8_STAGE(PG8_SB(0, 0), b2, vB2); PG8_STAGE(PG8_SB(0, 1), b2 + hs2, vB2); PG8_STAGE(PG8_SA(0, 0), a2, vA2[0]);
            PG8_WAIT_V(8); PG8_WAIT_L(0); PG8_BAR; PG8_MMA(1, 0, At, B0); PG8_MMA(1, 1, At, B1); PG8_BAR; PG8_SCHED;
            PG8_LDB(B0, 1, 0); PG8_LDB(B1, 1, 1); PG8_SCHED; PG8_LDA(At, 1, 0); PG8_STAGE(PG8_SA(0, 1), a2, vA2[1]);
            PG8_WAIT_V(8); PG8_WAIT_L(0); PG8_BAR; PG8_MMA(0, 0, At, B0); PG8_MMA(0, 1, At, B1); PG8_BAR; PG8_SCHED;
            PG8_LDA(At, 1, 1); PG8_STAGE(PG8_SB(1, 0), b3, vB2); PG8_STAGE(PG8_SB(1, 1), b3 + hs2, vB2); PG8_STAGE(PG8_SA(1, 0), a3, vA2[0]);
            PG8_WAIT_V(8); PG8_WAIT_L(0); PG8_BAR; PG8_MMA(1, 0, At, B0); PG8_MMA(1, 1, At, B1); PG8_BAR; PG8_SCHED;
        }
        if (wr == 0) PG8_BAR;
        E(acc, cur, wr, wc, fr, fq);
        if (!has_next) break;
        if (cur.chain != 1) {
#pragma unroll
            for (int a = 0; a < 2; ++a)
#pragma unroll
                for (int b = 0; b < 2; ++b)
#pragma unroll
                    for (int m = 0; m < 4; ++m)
#pragma unroll
                        for (int n = 0; n < 2; ++n) acc[a][b][m][n] = (f32x4){0.f, 0.f, 0.f, 0.f};
        }
        cur = nxt; cA = nA; cB = nB; chs = nhs; ++ui;
#pragma unroll
        for (int i = 0; i < 2; ++i) { cvB[i] = nvB[i]; cvA[0][i] = nvA[0][i]; cvA[1][i] = nvA[1][i]; }
        if (wr == 1) PG8_BAR;
    }
    PG8_WAIT_V(0);
    PG8_BAR;
#undef PG8_SA
#undef PG8_SB
#undef PG8_STAGE
#undef PG8_LDA
#undef PG8_LDB
#undef PG8_MMA
#undef PG8_WAIT_V
#undef PG8_WAIT_L
#undef PG8_BAR
#undef PG8_SCHED
}

struct TileOrder {
    int nM, nN, nwg, G, c;
    __device__ void init(int nM_, int nN_, int G_, int c_) { nM = nM_; nN = nN_; nwg = nM * nN; G = G_; c = c_; }
    __device__ __forceinline__ bool tile(int i, int& pm, int& pn) const {
        const long L = (long)i * G + c; if (L >= nwg) return false;
        int wgid = (int)L; { const int q = nwg / NXCD, r = nwg % NXCD, xcd = wgid % NXCD, off = wgid / NXCD; wgid = (xcd < r ? xcd * (q + 1) : r * (q + 1) + (xcd - r) * q) + off; }
        const int nig = WGM * nN, gid = wgid / nig, fm = gid * WGM, gsz = (nM - fm) < WGM ? (nM - fm) : WGM;
        pm = fm + ((wgid % nig) % gsz); pn = (wgid % nig) / gsz; return true;
    }
};
struct DenseSched {
    TileOrder o; const char* A; const char* Bt; int K;
    __device__ __forceinline__ bool next(int i, Unit& u) const {
        int pm, pn; if (!o.tile(i, pm, pn)) return false;
        u.A = A + (size_t)pm * BM * K * 2; u.B = Bt + (size_t)pn * BM * K * 2; u.gl = nullptr; u.gcnt = 0; u.K = K; u.pm = pm; u.pn = pn; u.aux = 0; u.chain = 0; return true;
    }
};

struct EpiIn {
    static constexpr bool PERM = true;
    const float* bias; const float* rope; bf16_t *q, *k, *v, *u, *vgg, *ga, *gb;
    __device__ __forceinline__ void operator()(f32x4 (&acc)[2][2][4][2], const Unit& un, int wr, int wc, int fr, int fq) const {
        const int colt = un.pn * BM;
        int kind, ldc, cb; bf16_t* base;
        if (colt < OFF_K) { kind = 0; base = q; ldc = ATTN_W; cb = colt; }
        else if (colt < OFF_V) { kind = 0; base = k; ldc = KV_W; cb = colt - OFF_K; }
        else if (colt < OFF_U) { kind = 1; base = v; ldc = KV_W; cb = colt - OFF_V; }
        else if (colt < OFF_VG) { kind = 2; base = u; ldc = SGU_W; cb = colt - OFF_U; }
        else if (colt < OFF_GA) { kind = 2; base = vgg; ldc = SGU_W; cb = colt - OFF_VG; }
        else if (colt < OFF_GB) { kind = 3; base = ga; ldc = D_MODEL; cb = colt - OFF_GA; }
        else { kind = 3; base = gb; ldc = D_MODEL; cb = colt - OFF_GB; }
        const int row0 = un.pm * BM + wr * 64 + fr, col0 = wc * 32 + 8 * fq;
        f32x4 bv[2][2];
#pragma unroll
        for (int bj = 0; bj < 2; ++bj)
#pragma unroll
            for (int n = 0; n < 2; ++n) bv[bj][n] = *(const f32x4*)(bias + colt + col0 + bj * HALF + 4 * n);
        const bool do_rope = (kind == 0) && ((wc & 1) == 0);
#pragma unroll
        for (int ai = 0; ai < 2; ++ai)
#pragma unroll
            for (int m = 0; m < 4; ++m) {
                const int row = row0 + ai * HALF + m * 16;
                f32x4 cs0 = {1.f, 1.f, 1.f, 1.f}, cs1 = cs0, sn0 = {0.f, 0.f, 0.f, 0.f}, sn1 = sn0;
                if (do_rope && fq < 2) {
                    const f32x4* tp = (const f32x4*)(rope + (size_t)(row % SEQ) * 16);
                    const f32x4 t0 = tp[0], t1 = tp[1], t2 = tp[2], t3 = tp[3];
                    cs0 = (f32x4){t0[0], t0[2], t1[0], t1[2]}; sn0 = (f32x4){t0[1], t0[3], t1[1], t1[3]};
                    cs1 = (f32x4){t2[0], t2[2], t3[0], t3[2]}; sn1 = (f32x4){t2[1], t2[3], t3[1], t3[3]};
                    if (fq == 0) { sn0 = -sn0; sn1 = -sn1; }
                }
#pragma unroll
                for (int bj = 0; bj < 2; ++bj) {
                    f32x4 v0 = acc[ai][bj][m][0] + bv[bj][0], v1 = acc[ai][bj][m][1] + bv[bj][1];
                    if (do_rope) {
                        f32x4 p0, p1;
#pragma unroll
                        for (int j = 0; j < 4; ++j) { p0[j] = __shfl_xor(v0[j], 16); p1[j] = __shfl_xor(v1[j], 16); }
                        v0 = v0 * cs0 + p0 * sn0; v1 = v1 * cs1 + p1 * sn1;
                    } else if (kind == 2) {
#pragma unroll
                        for (int j = 0; j < 4; ++j) { v0[j] = fgelu(v0[j]); v1[j] = fgelu(v1[j]); }
                    } else if (kind == 3) {
#pragma unroll
                        for (int j = 0; j < 4; ++j) { v0[j] = fsigmoid(v0[j]); v1[j] = fsigmoid(v1[j]); }
                    }
                    u32x4 w; w.x = cvt_pk_bf16(v0[0], v0[1]); w.y = cvt_pk_bf16(v0[2], v0[3]); w.z = cvt_pk_bf16(v1[0], v1[1]); w.w = cvt_pk_bf16(v1[2], v1[3]);
                    *(u32x4*)(base + (size_t)row * ldc + cb + col0 + bj * HALF) = w;
                }
            }
    }
};

__device__ __forceinline__ void unpack8(const u32x4 w, float (&f)[8]) {
#pragma unroll
    for (int j = 0; j < 4; ++j) { f[2 * j] = __uint_as_float(w[j] << 16); f[2 * j + 1] = __uint_as_float(w[j] & 0xffff0000u); }
}
struct EpiMerge {
    static constexpr bool PERM = true;
    const bf16_t* ga; const bf16_t* gb; bf16_t* merged;
    __device__ __forceinline__ void operator()(f32x4 (&acc)[2][2][4][2], const Unit& un, int wr, int wc, int fr, int fq) const {
        const int row0 = un.pm * BM + wr * 64 + fr, col0 = un.pn * BM + wc * 32 + 8 * fq;
#pragma unroll
        for (int ai = 0; ai < 2; ++ai)
#pragma unroll
            for (int m = 0; m < 4; ++m) {
                const size_t rowoff = (size_t)(row0 + ai * HALF + m * 16) * D_MODEL + col0;
#pragma unroll
                for (int bj = 0; bj < 2; ++bj) {
                    const size_t off = rowoff + bj * HALF;
                    float fb[8]; unpack8(*(const u32x4*)(gb + off), fb);
                    if (un.chain == 1) {
                        float fa[8]; unpack8(*(const u32x4*)(ga + off), fa);
#pragma unroll
                        for (int j = 0; j < 4; ++j) { acc[ai][bj][m][0][j] *= fa[j] * __builtin_amdgcn_rcpf(fb[j]); acc[ai][bj][m][1][j] *= fa[4 + j] * __builtin_amdgcn_rcpf(fb[4 + j]); }
                    } else {
                        f32x4 v0 = acc[ai][bj][m][0], v1 = acc[ai][bj][m][1];
#pragma unroll
                        for (int j = 0; j < 4; ++j) { v0[j] *= fb[j]; v1[j] *= fb[4 + j]; }
                        u32x4 w; w.x = cvt_pk_bf16(v0[0], v0[1]); w.y = cvt_pk_bf16(v0[2], v0[3]); w.z = cvt_pk_bf16(v1[0], v1[1]); w.w = cvt_pk_bf16(v1[2], v1[3]);
                        *(u32x4*)(merged + off) = w;
                    }
                }
            }
    }
};
struct EpiWo {
    static constexpr bool PERM = false;
    const float* x; float* out;
    __device__ __forceinline__ void operator()(f32x4 (&acc)[2][2][4][2], const Unit& un, int wr, int wc, int fr, int fq) const {
        const int row0 = un.pm * BM + wr * 64 + fr, col0 = un.pn * BM + wc * 32 + 4 * fq;
#pragma unroll
        for (int ai = 0; ai < 2; ++ai)
#pragma unroll
            for (int m = 0; m < 4; ++m) {
                const size_t rowoff = (size_t)(row0 + ai * HALF + m * 16) * D_MODEL + col0;
#pragma unroll
                for (int bj = 0; bj < 2; ++bj)
#pragma unroll
                    for (int n = 0; n < 2; ++n) { const size_t off = rowoff + bj * HALF + n * 16; const f32x4 xv = *(const f32x4*)(x + off); *(f32x4*)(out + off) = xv * ALPHA + acc[ai][bj][m][n]; }
            }
    }
};
struct EpiSwiglu {
    static constexpr bool PERM = true;
    bf16_t* H;
    __device__ __forceinline__ void operator()(f32x4 (&acc)[2][2][4][2], const Unit& un, int wr, int wc, int fr, int fq) const {
        const int row0 = un.aux + wr * 64 + fr, col0 = un.pn * HALF + wc * 32 + 8 * fq;
#pragma unroll
        for (int ai = 0; ai < 2; ++ai)
#pragma unroll
            for (int m = 0; m < 4; ++m) {
                f32x4 g0 = acc[ai][0][m][0], g1 = acc[ai][0][m][1]; const f32x4 u0 = acc[ai][1][m][0], u1 = acc[ai][1][m][1];
#pragma unroll
                for (int j = 0; j < 4; ++j) { g0[j] = g0[j] * fsigmoid(g0[j]) * u0[j]; g1[j] = g1[j] * fsigmoid(g1[j]) * u1[j]; }
                u32x4 w; w.x = cvt_pk_bf16(g0[0], g0[1]); w.y = cvt_pk_bf16(g0[2], g0[3]); w.z = cvt_pk_bf16(g1[0], g1[1]); w.w = cvt_pk_bf16(g1[2], g1[3]);
                *(u32x4*)(H + (size_t)(row0 + ai * HALF + m * 16) * DE + col0) = w;
            }
    }
};
struct EpiOut {
    static constexpr bool PERM = true;
    bf16_t* O;
    __device__ __forceinline__ void operator()(f32x4 (&acc)[2][2][4][2], const Unit& un, int wr, int wc, int fr, int fq) const {
        const int row0 = un.aux + wr * 64 + fr, col0 = un.pn * BM + wc * 32 + 8 * fq;
#pragma unroll
        for (int ai = 0; ai < 2; ++ai)
#pragma unroll
            for (int m = 0; m < 4; ++m)
#pragma unroll
                for (int bj = 0; bj < 2; ++bj) { const f32x4 v0 = acc[ai][bj][m][0], v1 = acc[ai][bj][m][1];
                    u32x4 w; w.x = cvt_pk_bf16(v0[0], v0[1]); w.y = cvt_pk_bf16(v0[2], v0[3]); w.z = cvt_pk_bf16(v1[0], v1[1]); w.w = cvt_pk_bf16(v1[2], v1[3]);
                    *(u32x4*)(O + (size_t)(row0 + ai * HALF + m * 16) * D_MODEL + col0 + bj * HALF) = w; }
    }
};
struct MergeSched {
    TileOrder o; const char* attn; const char* sgu; const char* WtA; const char* WtB;
    __device__ __forceinline__ bool next(int i, Unit& u) const {
        int pm, pn; if (!o.tile(i >> 1, pm, pn)) return false;
        u.gl = nullptr; u.gcnt = 0; u.pm = pm; u.pn = pn; u.aux = 0;
        if ((i & 1) == 0) { u.A = attn + (size_t)pm * BM * ATTN_W * 2; u.B = WtA + (size_t)pn * BM * ATTN_W * 2; u.K = ATTN_W; u.chain = 1; }
        else { u.A = sgu + (size_t)pm * BM * SGU_W * 2; u.B = WtB + (size_t)pn * BM * SGU_W * 2; u.K = SGU_W; u.chain = 2; }
        return true;
    }
};
struct MoeSched {
    TileOrder o; const LAS int* tab; const LAS int* pstart; const LAS int* cnt;
    int mode;
    const char* y1b; const int* tokl; const char* Wt13; const char* WtS13; const char* H; const char* Wt2; const char* WtS2;
    __device__ __forceinline__ bool next(int i, Unit& u) const {
        int pm, pn; if (!o.tile(i, pm, pn)) return false;
        const int ent = __builtin_amdgcn_readfirstlane(tab[pm]); const int e = ent & 255, j = ent >> 8;
        u.pm = pm; u.pn = pn; u.chain = 0; u.gl = nullptr; u.gcnt = 0;
        if (mode == 1) {
            u.K = D_MODEL;
            if (e < NE) { const int ps = __builtin_amdgcn_readfirstlane(pstart[e]), c = __builtin_amdgcn_readfirstlane(cnt[e]);
                u.A = y1b; u.gl = tokl + (size_t)e * 8192 + j * BM; u.gcnt = c - j * BM; u.B = Wt13 + ((size_t)e * 1024 + (size_t)pn * BM) * D_MODEL * 2; u.aux = ps + j * BM; }
            else { u.A = y1b + (size_t)j * BM * D_MODEL * 2; u.B = WtS13 + (size_t)pn * BM * D_MODEL * 2; u.aux = SLOT_ROWS + j * BM; }
        } else {
            u.K = DE;
            if (e < NE) { const int ps = __builtin_amdgcn_readfirstlane(pstart[e]);
                u.A = H + (size_t)(ps + j * BM) * DE * 2; u.B = Wt2 + ((size_t)e * D_MODEL + (size_t)pn * BM) * DE * 2; u.aux = ps + j * BM; }
            else { u.A = H + (size_t)(SLOT_ROWS + j * BM) * DE * 2; u.B = WtS2 + (size_t)pn * BM * DE * 2; u.aux = SLOT_ROWS + j * BM; }
        }
        return true;
    }
};
}

constexpr int NWAVES = 8;
constexpr int RING_OFF = 0, RING_BYTES = 131072;
constexpr int LDSCTL_OFF = RING_BYTES, MISC_OFF = LDSCTL_OFF + 320;
constexpr int LDS_BYTES = 147456;
constexpr int TAB_OFF = LDSCTL_OFF + 1024;
constexpr int CW_BAR = 4096;

#define XB_TMO      128
#define XB_XCNT(j)  (256  + 64 * (j))
#define XB_XSUB(j)  (1280 + 64 * (j))
#define XB_XGEN(j)  (2304 + 64 * (j))
#define XB_TOP      3328
#define XB_TOPGEN   3392
#define XCD_BAR_WORDS 3456
#define XB_SPIN_CAP (1u << 18)
__device__ __forceinline__ unsigned xb_ld(unsigned* p)              { return __hip_atomic_load(p, __ATOMIC_RELAXED, __HIP_MEMORY_SCOPE_AGENT); }
__device__ __forceinline__ unsigned xb_add(unsigned* p, unsigned v) { return __hip_atomic_fetch_add(p, v, __ATOMIC_RELAXED, __HIP_MEMORY_SCOPE_AGENT); }
__device__ __forceinline__ unsigned xb_xcc_id() { return (unsigned)__builtin_amdgcn_s_getreg((3 << 11) | 20) & 0xFu; }
#define XB_SPIN(cond, bar) do { unsigned _sp = 0; while (cond) { __builtin_amdgcn_s_sleep(1); \
    if ((++_sp & 255u) == 0u) { if (xb_ld(&(bar)[XB_TMO])) break; if (_sp > XB_SPIN_CAP) { atomicAdd(&(bar)[XB_TMO], 1u); break; } } } } while (0)
struct XcdBarrier { unsigned* bar; unsigned x; volatile LAS unsigned* st; };
__device__ __forceinline__ XcdBarrier xcd_barrier_post(unsigned* bar, volatile LAS unsigned* st) {
    XcdBarrier b; b.bar = bar; b.x = xb_xcc_id(); b.st = st;
    if (threadIdx.x == 0) (void)xb_add(&bar[XB_XCNT(b.x)], 1u);
    return b;
}
__device__ __forceinline__ void xcd_barrier_complete(unsigned* bar, unsigned x, unsigned& nloc, unsigned& nx) {
    const unsigned G = gridDim.x * gridDim.y * gridDim.z;
    unsigned sum, cnt, mine, sp = 0u;
    for (;;) {
        sum = 0u; cnt = 0u; mine = 0u;
#pragma unroll
        for (unsigned j = 0; j < 16; ++j) { const unsigned c = xb_ld(&bar[XB_XCNT(j)]); sum += c; cnt += (c > 0u) ? 1u : 0u; mine = (j == x) ? c : mine; }
        if (sum == G) break;
        __builtin_amdgcn_s_sleep(1);
        if ((++sp & 255u) == 0u) { if (xb_ld(&bar[XB_TMO])) break; if (sp > XB_SPIN_CAP) { atomicAdd(&bar[XB_TMO], 1u); break; } }
    }
    nloc = mine > 0u ? mine : 1u; nx = cnt > 0u ? cnt : 1u;
}
__device__ __forceinline__ void xcd_barrier(const XcdBarrier& b) {
    asm volatile("s_waitcnt vmcnt(0)" ::: "memory");
    __syncthreads();
    if (threadIdx.x == 0) {
        unsigned* bar = b.bar;
        __builtin_amdgcn_s_waitcnt(0);
        unsigned nloc = b.st[0], nx = b.st[1];
        if (nloc == 0u) { xcd_barrier_complete(bar, b.x, nloc, nx); b.st[0] = nloc; b.st[1] = nx; }
        const unsigned old = xb_add(&bar[XB_XSUB(b.x)], 1u);
        const unsigned gen = old / nloc;
        if (old + 1u == (gen + 1u) * nloc) {
            __builtin_amdgcn_fence(__ATOMIC_RELEASE, "agent");
            asm volatile("s_waitcnt vmcnt(0)" ::: "memory");
            const unsigned og = xb_add(&bar[XB_TOP], 1u);
            const unsigned tg = og / nx;
            if (og + 1u == (tg + 1u) * nx) xb_add(&bar[XB_TOPGEN], 1u);
            else XB_SPIN(xb_ld(&bar[XB_TOPGEN]) == tg, bar);
            __builtin_amdgcn_fence(__ATOMIC_ACQUIRE, "agent");
            xb_add(&bar[XB_XGEN(b.x)], 1u);
            asm volatile("s_waitcnt vmcnt(0)" ::: "memory");
        } else {
            XB_SPIN(xb_ld(&bar[XB_XGEN(b.x)]) == gen, bar);
            __builtin_amdgcn_fence(__ATOMIC_ACQUIRE, "agent");
            asm volatile("s_waitcnt vmcnt(0)" ::: "memory");
        }
    }
    __syncthreads();
}

#define LDS_WAIT() asm volatile("s_waitcnt lgkmcnt(0)" ::: "memory")
__device__ __forceinline__ void p0_transpose_item(const float* W, int K, int N, bf16_t* WT, int k0, int n0, int drow0, LAS float* scr, int lane) {
#pragma unroll 8
    for (int i = 0; i < 32; ++i) { const int kk = 2 * i + (lane >> 5); scr[kk * 33 + (lane & 31)] = W[(size_t)(k0 + kk) * N + n0 + (lane & 31)]; }
    LDS_WAIT(); asm volatile("" ::: "memory");
    const int c = lane & 7;
#pragma unroll
    for (int j = 0; j < 4; ++j) { const int n = (lane >> 3) + 8 * j; const LAS float* s = scr + (8 * c) * 33 + n;
        u32x4 o; o.x = pk2(s[0 * 33], s[1 * 33]); o.y = pk2(s[2 * 33], s[3 * 33]); o.z = pk2(s[4 * 33], s[5 * 33]); o.w = pk2(s[6 * 33], s[7 * 33]);
        *(u32x4*)(WT + (size_t)(drow0 + n) * K + k0 + 8 * c) = o; }
    LDS_WAIT(); asm volatile("" ::: "memory");
}

__device__ __forceinline__ float wave_sum(float v) {
#pragma unroll
    for (int o = 1; o < 64; o <<= 1) v += __shfl_xor(v, o);
    return v;
}
__device__ __forceinline__ int build_moe_table(LAS unsigned char* lds, const int* counts, int tid, int lane) {
    LAS int* tab = (LAS int*)(lds + TAB_OFF); LAS int* pstart = tab + 384; LAS int* cntl = pstart + 64; LAS int* ntot = cntl + 64;
    __syncthreads();
    if (tid < 64) {
        const int c = counts[tid]; const int nt = (c + 255) >> 8; int xs = nt;
#pragma unroll
        for (int o = 1; o < 64; o <<= 1) { const int v = __shfl_up(xs, o); if (lane >= o) xs += v; }
        const int ts = xs - nt;
        for (int j = 0; j < nt; ++j) tab[ts + j] = tid | (j << 8);
        pstart[tid] = ts * 256; cntl[tid] = c;
        if (tid == 63) ntot[0] = xs;
    }
    __syncthreads();
    const int NTr = ntot[0];
    if (tid >= 64 && tid < 96) tab[NTr + (tid - 64)] = 64 | ((tid - 64) << 8);
    __syncthreads();
    return NTr + NTOK / 256;
}
__device__ __forceinline__ void attn_unit(int unit, LAS unsigned char* lds, const bf16_t* Q, const bf16_t* K, const bf16_t* V, const float* sinks, bf16_t* O, int tid, int lane, int wave) {
    typedef float f32x16 __attribute__((ext_vector_type(16)));
    typedef unsigned u32x2 __attribute__((ext_vector_type(2)));
    const int hk = unit & 3, blk = unit >> 2, b = blk >> 5, ib = blk & 31;
    const int row0 = b * SEQ + ib * WINDOW;
    LAS bf16_t* Kl = (LAS bf16_t*)lds;
    LAS bf16_t* Vt = (LAS bf16_t*)(lds + 36864);
#pragma unroll
    for (int it = 0; it < 4; ++it) {
        const int ch = tid + 512 * it, j = ch >> 3, part = ch & 7;
        u32x4 kv = {0u, 0u, 0u, 0u}, vv = {0u, 0u, 0u, 0u};
        if (ib > 0 || j >= WINDOW) { const size_t gi = (size_t)(row0 - WINDOW + j) * KV_W + hk * HD + part * 8; kv = *(const u32x4*)(K + gi); vv = *(const u32x4*)(V + gi); }
        *(LAS u32x4*)(Kl + j * 72 + part * 8) = kv;
#pragma unroll
        for (int e = 0; e < 4; ++e) { Vt[(part * 8 + 2 * e) * 260 + j] = (bf16_t)(vv[e] & 0xffffu); Vt[(part * 8 + 2 * e + 1) * 260 + j] = (bf16_t)(vv[e] >> 16); }
    }
    __syncthreads();
    const int hq = hk * 8 + wave, ql = lane & 31, h = lane >> 5;
    const float LOG2E = 1.4426950408889634f, C2 = 0.125f * LOG2E;
    const float sink2 = sinks[hq] * LOG2E;
#pragma unroll 1
    for (int c = 0; c < 4; ++c) {
        const bf16_t* qp = Q + (size_t)(row0 + 32 * c + ql) * ATTN_W + hq * HD + 8 * h;
        bf16x8 qr[4];
#pragma unroll
        for (int s = 0; s < 4; ++s) qr[s] = *(const bf16x8*)(qp + 16 * s);
        f32x16 S[5];
#pragma unroll
        for (int kt = 0; kt < 5; ++kt) {
#pragma unroll
            for (int r = 0; r < 16; ++r) S[kt][r] = 0.f;
            const LAS bf16_t* kp = Kl + (32 * (c + kt) + ql) * 72 + 8 * h;
#pragma unroll
            for (int s = 0; s < 4; ++s) { const bf16x8 kf = *(const LAS bf16x8*)(kp + 16 * s); S[kt] = __builtin_amdgcn_mfma_f32_32x32x16_bf16(kf, qr[s], S[kt], 0, 0, 0); }
        }
        float mx = -INFINITY;
#pragma unroll
        for (int kt = 0; kt < 5; ++kt)
#pragma unroll
            for (int r = 0; r < 16; ++r) {
                const int cr = (r & 3) + 8 * (r >> 2) + 4 * h;
                bool valid = true;
                if (kt == 0) valid = cr > ql;
                if (kt == 4) valid = cr <= ql;
                if (ib == 0 && (c + kt) < 4) valid = false;
                const float t = valid ? S[kt][r] * C2 : -INFINITY;
                S[kt][r] = t; mx = fmaxf(mx, t);
            }
        mx = fmaxf(mx, __shfl_xor(mx, 32)); mx = fmaxf(mx, sink2);
        float l = 0.f;
#pragma unroll
        for (int kt = 0; kt < 5; ++kt)
#pragma unroll
            for (int r = 0; r < 16; ++r) { const float p = __builtin_amdgcn_exp2f(S[kt][r] - mx); S[kt][r] = p; l += p; }
        l += __shfl_xor(l, 32); l += __builtin_amdgcn_exp2f(sink2 - mx);
        f32x16 OT[2];
#pragma unroll
        for (int r = 0; r < 16; ++r) { OT[0][r] = 0.f; OT[1][r] = 0.f; }
#pragma unroll
        for (int kt = 0; kt < 5; ++kt)
#pragma unroll
            for (int s = 0; s < 2; ++s) {
                u32x4 pw;
#pragma unroll
                for (int j = 0; j < 4; ++j) pw[j] = pg8::cvt_pk_bf16(S[kt][8 * s + 2 * j], S[kt][8 * s + 2 * j + 1]);
                const bf16x8 pf = __builtin_bit_cast(bf16x8, pw);
#pragma unroll
                for (int dt = 0; dt < 2; ++dt) {
                    const LAS bf16_t* vp = Vt + (32 * dt + ql) * 260 + 32 * (c + kt) + 16 * s + 4 * h;
                    const u32x2 lo = *(const LAS u32x2*)vp, hi = *(const LAS u32x2*)(vp + 8);
                    const u32x4 vw = {lo[0], lo[1], hi[0], hi[1]};
                    OT[dt] = __builtin_amdgcn_mfma_f32_32x32x16_bf16(__builtin_bit_cast(bf16x8, vw), pf, OT[dt], 0, 0, 0);
                }
            }
        const float inv = 1.f / l;
        bf16_t* op = O + (size_t)(row0 + 32 * c + ql) * ATTN_W + hq * HD + 4 * h;
#pragma unroll
        for (int dt = 0; dt < 2; ++dt)
#pragma unroll
            for (int rg = 0; rg < 4; ++rg) { u32x2 w; w[0] = pg8::cvt_pk_bf16(OT[dt][4 * rg] * inv, OT[dt][4 * rg + 1] * inv); w[1] = pg8::cvt_pk_bf16(OT[dt][4 * rg + 2] * inv, OT[dt][4 * rg + 3] * inv);
                *(u32x2*)(op + 32 * dt + 8 * rg) = w; }
    }
    __syncthreads();
}
__device__ __forceinline__ void sgu_unit(int unit, LAS unsigned char* lds, const bf16_t* vgg, const bf16_t* u, const float* lng, const float* lnb, const float* wsp, const float* bsp, bf16_t* out, int tid) {
    LAS float* vn = (LAS float*)lds;
    const int g = unit & 7, bc = unit >> 3;
    const int rowbase = bc * CHUNK;
    {
        const int r = tid >> 2, qd = tid & 3;
        const bf16_t* p = vgg + (size_t)(rowbase + r) * SGU_W + g * SGU_C + qd * 32;
        float f[32];
#pragma unroll
        for (int j = 0; j < 4; ++j) { float t8[8]; pg8::unpack8(*(const u32x4*)(p + 8 * j), t8);
#pragma unroll
            for (int e = 0; e < 8; ++e) f[8 * j + e] = t8[e]; }
        float s = 0.f;
#pragma unroll
        for (int j = 0; j < 32; ++j) s += f[j];
        s += __shfl_xor(s, 1); s += __shfl_xor(s, 2);
        const float mu = s * (1.f / SGU_C); float qq = 0.f;
#pragma unroll
        for (int j = 0; j < 32; ++j) { const float d = f[j] - mu; qq += d * d; }
        qq += __shfl_xor(qq, 1); qq += __shfl_xor(qq, 2);
        const float rstd = 1.f / sqrtf(qq * (1.f / SGU_C) + LN_EPS);
#pragma unroll
        for (int j = 0; j < 32; ++j) { const int c = qd * 32 + j; vn[r * 128 + c] = (f[j] - mu) * rstd * lng[g * SGU_C + c] + lnb[g * SGU_C + c]; }
    }
    __syncthreads();
    {
        const int c = tid & 127, tg = __builtin_amdgcn_readfirstlane(tid >> 7);
        for (int i = 0; i < 8; ++i) {
            const int tb = tg + 4 * i;
            const float* w0 = wsp + ((size_t)g * CHUNK + 4 * tb) * CHUNK;
            float acc[4] = {0.f, 0.f, 0.f, 0.f};
            for (int s4 = 0; s4 <= tb; ++s4) {
                float v4[4];
#pragma unroll
                for (int ss = 0; ss < 4; ++ss) v4[ss] = vn[(4 * s4 + ss) * 128 + c];
#pragma unroll
                for (int tt = 0; tt < 4; ++tt) {
                    const f32x4 wr4 = *(const f32x4*)(w0 + tt * CHUNK + 4 * s4);
#pragma unroll
                    for (int ss = 0; ss < 4; ++ss) { const float wv = (s4 < tb || ss <= tt) ? wr4[ss] : 0.f; acc[tt] += wv * v4[ss]; }
                }
            }
#pragma unroll
            for (int tt = 0; tt < 4; ++tt) { const int t = 4 * tb + tt; const size_t o = (size_t)(rowbase + t) * SGU_W + g * SGU_C + c;
                out[o] = f2bf(bf2f(u[o]) * (acc[tt] + bsp[g * CHUNK + t])); }
        }
    }
    __syncthreads();
}
__device__ __forceinline__ void route_row(int t, float logit, const float* rbias, int* counts, int* tokl, int* slot_e, int* slot_p, float* slot_w, int lane) {
    const float score = sigmoidf_(logit);
    const float biased = score + rbias[lane];
    const int grp = lane >> 3;
    float m1 = biased;
#pragma unroll
    for (int o = 1; o < 8; o <<= 1) m1 = fmaxf(m1, __shfl_xor(m1, o));
    const unsigned long long eq = __ballot(biased == m1) & (0xFFull << (grp * 8));
    const int first = __ffsll((long long)eq) - 1;
    float m2 = (lane == first) ? -INFINITY : biased;
#pragma unroll
    for (int o = 1; o < 8; o <<= 1) m2 = fmaxf(m2, __shfl_xor(m2, o));
    const float gs = m1 + m2;
    int grank = 0;
#pragma unroll
    for (int g2 = 0; g2 < NGRP; ++g2) { const float o = __shfl(gs, g2 * 8); grank += (o > gs || (o == gs && g2 < grp)) ? 1 : 0; }
    const bool gsel = grank < TOPKG;
    const float masked = gsel ? biased : -INFINITY;
    int rank = 0;
    for (int e2 = 0; e2 < NE; ++e2) { const float o = __shfl(masked, e2); rank += (o > masked || (o == masked && e2 < lane)) ? 1 : 0; }
    const bool sel = gsel && rank < TOPK;
    const float wsum = wave_sum(sel ? score : 0.f);
    const unsigned long long sb = __ballot(sel);
    if (sel) {
        const int kidx = __popcll(sb & ((1ull << lane) - 1ull));
        const int pos = atomicAdd(&counts[lane], 1);
        tokl[(size_t)lane * 8192 + pos] = t;
        slot_e[t * TOPK + kidx] = lane; slot_p[t * TOPK + kidx] = pos; slot_w[t * TOPK + kidx] = score / (wsum + 1e-20f) * ROUTED_SCALE;
    }
}

struct Args { const float* in[23]; float* out; unsigned char* ws; int ph_lo, ph_hi, li, pad; };

__global__ void __launch_bounds__(NWAVES * 64, 2) mk_fwd(Args args) {
    extern __shared__ __attribute__((aligned(16))) unsigned char lds_raw[];
    LAS unsigned char* lds = (LAS unsigned char*)lds_raw;
    volatile LAS unsigned* MISC = (volatile LAS unsigned*)(lds + MISC_OFF);
    const int tid = threadIdx.x, lane = tid & 63, wave = __builtin_amdgcn_readfirstlane(tid >> 6);
    const int G = gridDim.x; const int bx = blockIdx.x; const int vcu = (G % 8 == 0) ? (bx % 8) * (G / 8) + bx / 8 : bx;
    unsigned char* ws = args.ws;
    unsigned* ctl = (unsigned*)(ws + WS_CTL);
    for (int u = tid; u < (LDS_BYTES - LDSCTL_OFF) / 4; u += NWAVES * 64) ((LAS unsigned*)(lds + LDSCTL_OFF))[u] = 0u;
    __syncthreads();
    XcdBarrier bar = xcd_barrier_post(ctl + CW_BAR + args.li * XCD_BAR_WORDS, MISC + 8);
    const int lo = args.ph_lo, hi = args.ph_hi;
#define IN(k) (lo <= (k) && (k) < hi)
#define BOTH(k) (IN(k) && IN((k) + 1))

    if (IN(0)) {
        LAS float* scr = (LAS float*)(lds + RING_OFF + wave * 16384);
        const int gw = vcu * NWAVES + wave, NGW = G * NWAVES;
        const float* w_in = args.in[1]; const float* wA = args.in[8]; const float* wB = args.in[9]; const float* wo = args.in[10];
        const float* w1 = args.in[15]; const float* w3 = args.in[16]; const float* w2 = args.in[17]; const float* ws1 = args.in[18]; const float* ws3 = args.in[19]; const float* ws2 = args.in[20];
        bf16_t* WtIn = (bf16_t*)(ws + WS_WTIN); bf16_t* WtA = (bf16_t*)(ws + WS_WTA); bf16_t* WtB = (bf16_t*)(ws + WS_WTB); bf16_t* WtO = (bf16_t*)(ws + WS_WTO);
        bf16_t* Wt13 = (bf16_t*)(ws + WS_WT13); bf16_t* Wt2 = (bf16_t*)(ws + WS_WT2); bf16_t* WtS13 = (bf16_t*)(ws + WS_WTS13); bf16_t* WtS2 = (bf16_t*)(ws + WS_WTS2);
        constexpr int I_IN = (D_MODEL / 64) * (IN_W / 32), I_A = (ATTN_W / 64) * (D_MODEL / 32), I_B = (SGU_W / 64) * (D_MODEL / 32), I_O = (D_MODEL / 64) * (D_MODEL / 32);
        constexpr int I_E1 = (D_MODEL / 64) * (DE / 32);
        constexpr int I_E2 = (DE / 64) * (D_MODEL / 32);
        constexpr int I_W1 = NE * I_E1, I_W2 = NE * I_E2;
        constexpr int NITEMS = I_IN + I_A + I_B + I_O + 2 * I_W1 + I_W2 + 2 * I_E1 + I_E2;
        for (int it = gw; it < NITEMS; it += NGW) {
            int r = it;
            if (r < I_IN) { const int nb = IN_W / 32; p0_transpose_item(w_in, D_MODEL, IN_W, WtIn, 64 * (r / nb), 32 * (r % nb), 32 * (r % nb), scr, lane); continue; } r -= I_IN;
            if (r < I_A) { const int nb = D_MODEL / 32; p0_transpose_item(wA, ATTN_W, D_MODEL, WtA, 64 * (r / nb), 32 * (r % nb), 32 * (r % nb), scr, lane); continue; } r -= I_A;
            if (r < I_B) { const int nb = D_MODEL / 32; p0_transpose_item(wB, SGU_W, D_MODEL, WtB, 64 * (r / nb), 32 * (r % nb), 32 * (r % nb), scr, lane); continue; } r -= I_B;
            if (r < I_O) { const int nb = D_MODEL / 32; p0_transpose_item(wo, D_MODEL, D_MODEL, WtO, 64 * (r / nb), 32 * (r % nb), 32 * (r % nb), scr, lane); continue; } r -= I_O;
            if (r < 2 * I_W1) {
                const int which = r / I_W1; const int rr = r % I_W1; const int e = rr / I_E1, q = rr % I_E1; const int nb = DE / 32; const int k0 = 64 * (q / nb), n0 = 32 * (q % nb);
                const float* src = (which ? w3 : w1) + (size_t)e * D_MODEL * DE;
                p0_transpose_item(src, D_MODEL, DE, Wt13 + (size_t)e * 1024 * D_MODEL, k0, n0, (n0 / 128) * 256 + (n0 % 128) + which * 128, scr, lane); continue; } r -= 2 * I_W1;
            if (r < I_W2) { const int e = r / I_E2, q = r % I_E2; const int nb = D_MODEL / 32; const int k0 = 64 * (q / nb), n0 = 32 * (q % nb);
                p0_transpose_item(w2 + (size_t)e * DE * D_MODEL, DE, D_MODEL, Wt2 + (size_t)e * D_MODEL * DE, k0, n0, n0, scr, lane); continue; } r -= I_W2;
            if (r < 2 * I_E1) { const int which = r / I_E1, q = r % I_E1; const int nb = DS / 32; const int k0 = 64 * (q / nb), n0 = 32 * (q % nb);
                p0_transpose_item(which ? ws3 : ws1, D_MODEL, DS, WtS13, k0, n0, (n0 / 128) * 256 + (n0 % 128) + which * 128, scr, lane); continue; } r -= 2 * I_E1;
            { const int nb = D_MODEL / 32; p0_transpose_item(ws2, DS, D_MODEL, WtS2, 64 * (r / nb), 32 * (r % nb), 32 * (r % nb), scr, lane); }
        }
        { const float* x = args.in[0]; bf16_t* xb = (bf16_t*)(ws + WS_XB); const size_t n8 = (size_t)NTOK * D_MODEL / 8;
          for (size_t i = (size_t)vcu * 512 + tid; i < n8; i += (size_t)G * 512) { const f32x4 a = *(const f32x4*)(x + 8 * i), b = *(const f32x4*)(x + 8 * i + 4);
              u32x4 o; o.x = pk2(a[0], a[1]); o.y = pk2(a[2], a[3]); o.z = pk2(b[0], b[1]); o.w = pk2(b[2], b[3]); *(u32x4*)(xb + 8 * i) = o; } }
        { float* tab = (float*)(ws + WS_ROPE);
          for (int i = vcu * 512 + tid; i < SEQ * 8; i += G * 512) { const int pos = i >> 3, f = i & 7; const float invf = (float)pow(500000.0, -(double)f / 8.0); const float ang = (float)pos * invf;
              tab[2 * i] = (float)cos((double)ang); tab[2 * i + 1] = (float)sin((double)ang); } }
        { bf16_t* y1b = (bf16_t*)(ws + WS_Y1B); for (int i = vcu * 512 + tid; i < D_MODEL; i += G * 512) y1b[(size_t)NTOK * D_MODEL + i] = 0; }
        if (BOTH(0)) xcd_barrier(bar);
    }

    if (IN(1)) {
        pg8::DenseSched S; S.o.init(NTOK / 256, IN_W / 256, G, bx); S.A = (const char*)(ws + WS_XB); S.Bt = (const char*)(ws + WS_WTIN); S.K = D_MODEL;
        pg8::EpiIn E{args.in[2], (const float*)(ws + WS_ROPE), (bf16_t*)(ws + WS_Q), (bf16_t*)(ws + WS_K), (bf16_t*)(ws + WS_V), (bf16_t*)(ws + WS_U), (bf16_t*)(ws + WS_VGG), (bf16_t*)(ws + WS_GA), (bf16_t*)(ws + WS_GB)};
        pg8::gemm_phase<pg8::EpiIn, pg8::DenseSched>(lds + RING_OFF, S, E);
        if (BOTH(1)) xcd_barrier(bar);
    }

    if (IN(2)) {
        const bf16_t* q = (const bf16_t*)(ws + WS_Q); const bf16_t* k = (const bf16_t*)(ws + WS_K); const bf16_t* v = (const bf16_t*)(ws + WS_V);
        for (int un = vcu; un < BATCH * (SEQ / WINDOW) * NKVH; un += G) attn_unit(un, lds, q, k, v, args.in[3], (bf16_t*)(ws + WS_ATTN), tid, lane, wave);
        for (int un = vcu; un < BATCH * (SEQ / CHUNK) * SGU_G; un += G)
            sgu_unit(un, lds, (const bf16_t*)(ws + WS_VGG), (const bf16_t*)(ws + WS_U), args.in[4], args.in[5], args.in[6], args.in[7], (bf16_t*)(ws + WS_SGU), tid);
        if (BOTH(2)) xcd_barrier(bar);
    }
    if (IN(3)) {
        pg8::MergeSched S; S.o.init(NTOK / 256, D_MODEL / 256, G, bx); S.attn = (const char*)(ws + WS_ATTN); S.sgu = (const char*)(ws + WS_SGU); S.WtA = (const char*)(ws + WS_WTA); S.WtB = (const char*)(ws + WS_WTB);
        pg8::EpiMerge E{(const bf16_t*)(ws + WS_GA), (const bf16_t*)(ws + WS_GB), (bf16_t*)(ws + WS_MERGED)};
        pg8::gemm_phase<pg8::EpiMerge, pg8::MergeSched>(lds + RING_OFF, S, E);
        if (BOTH(3)) xcd_barrier(bar);
    }
    if (IN(4)) {
        pg8::DenseSched S; S.o.init(NTOK / 256, D_MODEL / 256, G, bx); S.A = (const char*)(ws + WS_MERGED); S.Bt = (const char*)(ws + WS_WTO); S.K = D_MODEL;
        pg8::EpiWo E{args.in[0], (float*)(ws + WS_Y1PRE)};
        pg8::gemm_phase<pg8::EpiWo, pg8::DenseSched>(lds + RING_OFF, S, E);
        if (BOTH(4)) xcd_barrier(bar);
    }
    if (IN(5)) {
        const float* y1pre = (const float*)(ws + WS_Y1PRE); float* y1 = (float*)(ws + WS_Y1); bf16_t* y1b = (bf16_t*)(ws + WS_Y1B);
        const float* g1 = args.in[11]; const float* b1 = args.in[12]; const float* wr = args.in[13];
        LAS float* yn = (LAS float*)lds;
        for (int tile = vcu; tile < NTOK / 16; tile += G) {
            const int r0 = tile * 16;
#pragma unroll 1
            for (int rr = 0; rr < 2; ++rr) {
                const int r = wave * 2 + rr; const size_t ro = (size_t)(r0 + r) * D_MODEL;
                f32x4 v[8]; float s = 0.f;
#pragma unroll
                for (int j = 0; j < 8; ++j) { v[j] = *(const f32x4*)(y1pre + ro + lane * 4 + 256 * j); s += (v[j][0] + v[j][1]) + (v[j][2] + v[j][3]); }
                const float mu = wave_sum(s) * (1.f / D_MODEL); float qq = 0.f;
#pragma unroll
                for (int j = 0; j < 8; ++j) { v[j] = v[j] - mu; qq += (v[j][0] * v[j][0] + v[j][1] * v[j][1]) + (v[j][2] * v[j][2] + v[j][3] * v[j][3]); }
                const float rstd = 1.f / sqrtf(wave_sum(qq) * (1.f / D_MODEL) + LN_EPS);
#pragma unroll
                for (int j = 0; j < 8; ++j) { const int c = lane * 4 + 256 * j; const f32x4 o = v[j] * rstd * *(const f32x4*)(g1 + c) + *(const f32x4*)(b1 + c);
                    *(f32x4*)(y1 + ro + c) = o; f32x2 pk; pk[0] = __uint_as_float(pk2(o[0], o[1])); pk[1] = __uint_as_float(pk2(o[2], o[3])); *(f32x2*)(y1b + ro + c) = pk;
                    *(LAS f32x4*)(yn + r * D_MODEL + c) = o; }
            }
            __syncthreads();
            float acc[16];
#pragma unroll
            for (int r = 0; r < 16; ++r) acc[r] = 0.f;
            for (int d = wave * 256; d < wave * 256 + 256; d += 4) {
                float wv[4];
#pragma unroll
                for (int i = 0; i < 4; ++i) wv[i] = wr[(size_t)(d + i) * NE + lane];
#pragma unroll
                for (int r = 0; r < 16; ++r) { const f32x4 y4 = *(const LAS f32x4*)(yn + r * D_MODEL + d); acc[r] += (y4[0] * wv[0] + y4[1] * wv[1]) + (y4[2] * wv[2] + y4[3] * wv[3]); }
            }
            __syncthreads();
#pragma unroll
            for (int r = 0; r < 16; ++r) yn[(wave * 16 + r) * NE + lane] = acc[r];
            __syncthreads();
#pragma unroll 1
            for (int rr = 0; rr < 2; ++rr) {
                const int r = wave * 2 + rr; float lg = 0.f;
#pragma unroll
                for (int w2 = 0; w2 < 8; ++w2) lg += yn[(w2 * 16 + r) * NE + lane];
                route_row(r0 + r, lg, args.in[14], (int*)(ws + WS_CTL), (int*)(ws + WS_TOKL), (int*)(ws + WS_SLOT_E), (int*)(ws + WS_SLOT_P), (float*)(ws + WS_SLOT_W), lane);
            }
            __syncthreads();
        }
        if (BOTH(5)) xcd_barrier(bar);
    }
    if (IN(6) || IN(7)) {
        LAS int* tab = (LAS int*)(lds + TAB_OFF); LAS int* pstart = tab + 384; LAS int* cntl = pstart + 64;
        const int NT = build_moe_table(lds, (const int*)(ws + WS_CTL), tid, lane);
        pg8::MoeSched S; S.tab = tab; S.pstart = pstart; S.cnt = cntl;
        S.y1b = (const char*)(ws + WS_Y1B); S.tokl = (const int*)(ws + WS_TOKL); S.Wt13 = (const char*)(ws + WS_WT13); S.WtS13 = (const char*)(ws + WS_WTS13);
        S.H = (const char*)(ws + WS_H); S.Wt2 = (const char*)(ws + WS_WT2); S.WtS2 = (const char*)(ws + WS_WTS2);
        if (IN(6)) {
            S.mode = 1; S.o.init(NT, 4, G, bx);
            pg8::EpiSwiglu E{(bf16_t*)(ws + WS_H)};
            pg8::gemm_phase<pg8::EpiSwiglu, pg8::MoeSched>(lds + RING_OFF, S, E);
            if (BOTH(6)) xcd_barrier(bar);
        }
        if (IN(7)) {
            S.mode = 2; S.o.init(NT, 8, G, bx);
            pg8::EpiOut E{(bf16_t*)(ws + WS_OUT)};
            pg8::gemm_phase<pg8::EpiOut, pg8::MoeSched>(lds + RING_OFF, S, E);
            if (BOTH(7)) xcd_barrier(bar);
        }
    }

    if (IN(8)) {
        (void)build_moe_table(lds, (const int*)(ws + WS_CTL), tid, lane);
        const LAS int* pstart = (const LAS int*)(lds + TAB_OFF) + 384;
        const float* y1 = (const float*)(ws + WS_Y1); const bf16_t* OUTB = (const bf16_t*)(ws + WS_OUT); const bf16_t* shout = OUTB + (size_t)SLOT_ROWS * D_MODEL;
        const int* slot_e = (const int*)(ws + WS_SLOT_E); const int* slot_p = (const int*)(ws + WS_SLOT_P); const float* slot_w = (const float*)(ws + WS_SLOT_W);
        const float* g2 = args.in[21]; const float* b2 = args.in[22];
        for (int row = vcu * NWAVES + wave; row < NTOK; row += G * NWAVES) {
            const size_t ro = (size_t)row * D_MODEL;
            f32x4 v[8];
#pragma unroll
            for (int j = 0; j < 8; ++j) { const int c = lane * 4 + 256 * j; const f32x2 sh = *(const f32x2*)(shout + ro + c); const unsigned s0 = __float_as_uint(sh[0]), s1 = __float_as_uint(sh[1]);
                v[j] = *(const f32x4*)(y1 + ro + c) * ALPHA + (f32x4){__uint_as_float(s0 << 16), __uint_as_float(s0 & 0xffff0000u), __uint_as_float(s1 << 16), __uint_as_float(s1 & 0xffff0000u)}; }
#pragma unroll 1
            for (int kk = 0; kk < TOPK; ++kk) {
                const int e = __builtin_amdgcn_readfirstlane(slot_e[row * TOPK + kk]), p = __builtin_amdgcn_readfirstlane(slot_p[row * TOPK + kk]); const float w = slot_w[row * TOPK + kk];
                const bf16_t* srcp = OUTB + (size_t)(pstart[e] + p) * D_MODEL;
#pragma unroll
                for (int j = 0; j < 8; ++j) { const int c = lane * 4 + 256 * j; const f32x2 sh = *(const f32x2*)(srcp + c); const unsigned s0 = __float_as_uint(sh[0]), s1 = __float_as_uint(sh[1]);
                    v[j] = v[j] + (f32x4){__uint_as_float(s0 << 16), __uint_as_float(s0 & 0xffff0000u), __uint_as_float(s1 << 16), __uint_as_float(s1 & 0xffff0000u)} * w; }
            }
            float s = 0.f;
#pragma unroll
            for (int j = 0; j < 8; ++j) s += (v[j][0] + v[j][1]) + (v[j][2] + v[j][3]);
            const float mu = wave_sum(s) * (1.f / D_MODEL); float qq = 0.f;
#pragma unroll
            for (int j = 0; j < 8; ++j) { v[j] = v[j] - mu; qq += (v[j][0] * v[j][0] + v[j][1] * v[j][1]) + (v[j][2] * v[j][2] + v[j][3] * v[j][3]); }
            const float rstd = 1.f / sqrtf(wave_sum(qq) * (1.f / D_MODEL) + LN_EPS);
#pragma unroll
            for (int j = 0; j < 8; ++j) { const int c = lane * 4 + 256 * j; *(f32x4*)(args.out + ro + c) = v[j] * rstd * *(const f32x4*)(g2 + c) + *(const f32x4*)(b2 + c); }
        }
    }
#undef IN
#undef BOTH
}

extern "C" void kernel_launch(void* const* d_in, const int* in_sizes, int n_in, void* d_out, int out_size, void* d_ws, size_t ws_size, hipStream_t stream) {
    static int grid = 0;
    if (grid == 0) {
        if (n_in != 23 || ws_size < WS_END) { fprintf(stderr, "kernel_launch: unexpected n_in %d / ws %zu (need %zu)\n", n_in, ws_size, (size_t)WS_END); grid = -1; return; }
        int dev = 0, cus = 0;
        if (hipGetDevice(&dev) != hipSuccess || hipDeviceGetAttribute(&cus, hipDeviceAttributeMultiprocessorCount, dev) != hipSuccess) { grid = -1; return; }
        if (hipFuncSetAttribute((const void*)mk_fwd, hipFuncAttributeMaxDynamicSharedMemorySize, LDS_BYTES) != hipSuccess) { fprintf(stderr, "kernel_launch: hipFuncSetAttribute failed\n"); grid = -1; return; }
        (void)hipGetLastError();
        grid = cus;
    }
    if (grid < 0) return;
    char* ws = (char*)d_ws;
    if (hipMemsetAsync(ws + WS_CTL, 0, CTL_ZERO_BYTES, stream) != hipSuccess) { fprintf(stderr, "kernel_launch: memset failed\n"); return; }
    Args a{};
    for (int i = 0; i < 23; ++i) a.in[i] = (const float*)d_in[i];
    a.out = (float*)d_out; a.ws = (unsigned char*)d_ws; a.ph_lo = 0; a.ph_hi = 9; a.li = 0;
    hipLaunchKernelGGL(mk_fwd, dim3(grid), dim3(NWAVES * 64), LDS_BYTES, stream, a);
}
```
